# Optimizing an MI355X kernel written in HIP

```python
import jax, jax.numpy as jnp
from jax import lax
import numpy as np

D_MODEL = 2048
BATCH = 2
SEQ = 8192
DEPTH = 2

N_MIXERS = 2
EPS = 1e-6
CONV_WIDTH = 3
CONV_DIM = D_MODEL
GLA_HEADS = 4
GLA_KEY_DIM = D_MODEL // 2
GLA_VAL_DIM = D_MODEL
GLA_HEAD_K = GLA_KEY_DIM // GLA_HEADS
GLA_HEAD_V = GLA_VAL_DIM // GLA_HEADS
GLA_GATE_RANK = 16
GATE_LOGIT_NORMALIZER = 16.0
GLA_CHUNK = 64
GLA_IN_DIM = 2 * GLA_KEY_DIM + 2 * GLA_VAL_DIM + GLA_GATE_RANK

kernel_name = "hybrid_shortconv_gla_interleaved"


def rmsnorm(x, w):
    x32 = x.astype(jnp.float32)
    y = x32 * lax.rsqrt(jnp.mean(x32 * x32, axis=-1, keepdims=True) + EPS)
    return (y * w.astype(jnp.float32)).astype(x.dtype)


def short_conv_mixer(h, w_in, w_conv, w_out):
    T = h.shape[1]
    proj = h @ w_in
    b_gate, c_gate, u, z = jnp.split(proj, 4, axis=-1)
    cu = c_gate * u
    pad = jnp.pad(cu, ((0, 0), (CONV_WIDTH - 1, 0), (0, 0)))
    conv = pad[:, 0:T, :] * w_conv[:, 0]
    for k in range(1, CONV_WIDTH):
        conv = conv + pad[:, k:k + T, :] * w_conv[:, k]
    y = b_gate * conv * jax.nn.silu(z)
    return y @ w_out


def _to_chunks(t, d):
    Bsz, T, _ = t.shape
    t = t.reshape(Bsz, T // GLA_CHUNK, GLA_CHUNK, GLA_HEADS, d)
    return jnp.transpose(t, (1, 0, 3, 2, 4))


def gla_mixer(h, w_in, w_gk2, b_gk2, gn_w, w_out):
    Bsz, T, _ = h.shape
    dtype = h.dtype
    proj = h @ w_in
    s1, s2, s3, s4 = GLA_KEY_DIM, 2 * GLA_KEY_DIM, 2 * GLA_KEY_DIM + GLA_VAL_DIM, 2 * GLA_KEY_DIM + 2 * GLA_VAL_DIM
    q, k, v, g, gk_lr = proj[..., :s1], proj[..., s1:s2], proj[..., s2:s3], proj[..., s3:s4], proj[..., s4:]
    log_alpha = jax.nn.log_sigmoid((gk_lr @ w_gk2 + b_gk2).astype(jnp.float32)) / GATE_LOGIT_NORMALIZER

    qc = _to_chunks(q.astype(jnp.float32) * (GLA_HEAD_K ** -0.5), GLA_HEAD_K)
    kc = _to_chunks(k.astype(jnp.float32), GLA_HEAD_K)
    vc = _to_chunks(v.astype(jnp.float32), GLA_HEAD_V)
    bc = jnp.cumsum(_to_chunks(log_alpha, GLA_HEAD_K), axis=3)
    causal = jnp.tril(jnp.ones((GLA_CHUNK, GLA_CHUNK), dtype=bool))

    def step(S, inp):
        qi, ki, vi, bi = inp
        inter = jnp.einsum('bhid,bhde->bhie', qi * jnp.exp(bi), S)
        diff = bi[:, :, :, None, :] - bi[:, :, None, :, :]
        decay = jnp.where(causal[:, :, None], jnp.exp(jnp.minimum(diff, 0.0)), 0.0)
        scores = jnp.einsum('bhid,bhjd,bhijd->bhij', qi, ki, decay)
        intra = jnp.einsum('bhij,bhje->bhie', scores, vi)
        b_last = bi[:, :, -1:, :]
        S_new = jnp.exp(b_last)[:, :, 0, :, None] * S + jnp.einsum('bhjd,bhje->bhde', ki * jnp.exp(b_last - bi), vi)
        return S_new, inter + intra

    S0 = jnp.zeros((Bsz, GLA_HEADS, GLA_HEAD_K, GLA_HEAD_V), jnp.float32)
    _, o = lax.scan(step, S0, (qc, kc, vc, bc))
    o = jnp.transpose(o, (1, 0, 3, 2, 4)).reshape(Bsz, T, GLA_HEADS, GLA_HEAD_V)
    o = o * lax.rsqrt(jnp.mean(o * o, axis=-1, keepdims=True) + EPS) * gn_w.astype(jnp.float32)
    o = o.reshape(Bsz, T, GLA_VAL_DIM).astype(dtype) * jax.nn.silu(g)
    return o @ w_out


def setup_inputs(seed: int = 0) -> dict:
    key = jax.random.key(seed)
    ks = jax.random.split(key, 16)
    nrm = lambda k, shape, s: jax.random.normal(k, shape, jnp.float32) * s
    return {
        "x": nrm(ks[0], (BATCH, SEQ, D_MODEL), 1.0),
        "norm0_w": 1.0 + nrm(ks[1], (D_MODEL,), 0.02),
        "conv0_w_in": nrm(ks[2], (D_MODEL, 4 * CONV_DIM), D_MODEL ** -0.5),
        "conv0_w_conv": nrm(ks[3], (CONV_DIM, CONV_WIDTH), CONV_WIDTH ** -0.5),
        "conv0_w_out": nrm(ks[4], (CONV_DIM, D_MODEL), CONV_DIM ** -0.5),
        "norm1_w": 1.0 + nrm(ks[5], (D_MODEL,), 0.02),
        "gla1_w_in": nrm(ks[6], (D_MODEL, GLA_IN_DIM), D_MODEL ** -0.5),
        "gla1_w_gk2": nrm(ks[7], (GLA_GATE_RANK, GLA_KEY_DIM), GLA_GATE_RANK ** -0.5),
        "gla1_b_gk2": nrm(ks[8], (GLA_KEY_DIM,), 0.01),
        "gla1_gn_w": 1.0 + nrm(ks[9], (GLA_HEAD_V,), 0.02),
        "gla1_w_out": nrm(ks[10], (GLA_VAL_DIM, D_MODEL), GLA_VAL_DIM ** -0.5),
        "norm_f_w": 1.0 + nrm(ks[11], (D_MODEL,), 0.02),
    }


def reference(x, norm0_w, conv0_w_in, conv0_w_conv, conv0_w_out, norm1_w, gla1_w_in, gla1_w_gk2, gla1_b_gk2, gla1_gn_w, gla1_w_out, norm_f_w):
    norms = [norm0_w, norm1_w]
    mixers = [
        lambda h: short_conv_mixer(h, conv0_w_in, conv0_w_conv, conv0_w_out),
        lambda h: gla_mixer(h, gla1_w_in, gla1_w_gk2, gla1_b_gk2, gla1_gn_w, gla1_w_out),
    ]
    for i in range(DEPTH):
        x = x + mixers[i % N_MIXERS](rmsnorm(x, norms[i]))
    return rmsnorm(x, norm_f_w)
```

```cpp
#include <hip/hip_runtime.h>
#include <hip/hip_cooperative_groups.h>
#include <cstdio>
#include <cstdint>
namespace cg = cooperative_groups;
namespace pg8 {
#define PG8_LAS __attribute__((address_space(3)))
typedef unsigned short bf16_t;
typedef short bf16x8 __attribute__((ext_vector_type(8)));
typedef float f32x4 __attribute__((ext_vector_type(4)));
typedef unsigned u32x4 __attribute__((ext_vector_type(4)));
constexpr int BM = 256, BK = 64, HALF = 128, HTB = HALF * BK * 2  , STAGE_BYTES = 8 * HTB, NXCD = 8, WGM = 8;

__host__ __device__ __forceinline__ int lds_byte(int r, int c) { const int st = (r >> 4) * 2 + (c >> 5), rr = r & 15, cc = c & 31, ob = rr * 64 + cc * 2; return st * 1024 + (ob ^ (((ob >> 9) & 1) << 5)); }
__host__ __device__ __forceinline__ void stage_rc(int b, int& R, int& C) { const int st = b / 1024, sb = b % 1024, swz = sb ^ (((sb >> 9) & 1) << 5); R = (st >> 1) * 16 + swz / 64; C = (st & 1) * 32 + (swz % 64) / 2; }
__host__ __device__ __forceinline__ int perm32(int rho) { const int n = rho >> 4, i = rho & 15; return 8 * (i >> 2) + 4 * n + (i & 3); }

struct Unit { int pm, pn; };
struct Gemm { const bf16_t* A; const bf16_t* Bt; int M, N, K; };

struct StaticOrder {
    int nM, nN, nwg, G, c;
    __host__ __device__ void init(int M, int N, int G_, int c_) { nM = M / BM; nN = N / BM; nwg = nM * nN; G = G_; c = c_; }
    __host__ __device__ bool next(int i, Unit& u) const {
        const long L = (long)i * G + c; if (L >= nwg) return false;
        int wgid = (int)L; { const int q = nwg / NXCD, r = nwg % NXCD, xcd = wgid % NXCD, off = wgid / NXCD; wgid = (xcd < r ? xcd * (q + 1) : r * (q + 1) + (xcd - r) * q) + off; }
        const int nig = WGM * nN, gid = wgid / nig, fm = gid * WGM, gsz = (nM - fm) < WGM ? (nM - fm) : WGM;
        u.pm = fm + ((wgid % nig) % gsz); u.pn = (wgid % nig) / gsz; return true;
    }
    __device__ __forceinline__ void a_ready(const Unit&) const {}
    __device__ __forceinline__ void done(const Unit&) const {}
};

__device__ __forceinline__ unsigned cvt_pk_bf16(float lo, float hi) { unsigned r; asm volatile("v_cvt_pk_bf16_f32 %0, %1, %2" : "=v"(r) : "v"(lo), "v"(hi)); return r; }
typedef float f32x2 __attribute__((ext_vector_type(2)));
typedef unsigned u32x2 __attribute__((ext_vector_type(2)));
constexpr float RMS_EPS = 1e-6f;
struct EpiConvFused {
    static constexpr bool PERM = false, AFTER_DRAIN = false;
    bf16_t* Y; const float* wconv; float* HA; float* HB; PG8_LAS float* xch;
    __device__ __forceinline__ void operator()(const f32x4 (&acc)[2][2][4][2], const Unit& u, int wr, int wc, int fr, int fq) const {
        const int row0 = u.pm * BM + wr * 64 + fr; const int ch = wc * 16 + 4 * fq, e0 = u.pn * 64 + ch;
        f32x4 w0, w1, w2;
#pragma unroll
        for (int j = 0; j < 4; ++j) { w0[j] = wconv[(e0 + j) * 3 + 0]; w1[j] = wconv[(e0 + j) * 3 + 1]; w2[j] = wconv[(e0 + j) * 3 + 2]; }
#pragma unroll
        for (int ai = 0; ai < 2; ++ai) { const f32x4 cu3 = acc[ai][0][3][1] * acc[ai][1][3][0];
            if (fr >= 14) *(PG8_LAS f32x4*)(xch + ((2 * ai + wr) * 2 + (fr - 14)) * 64 + ch) = cu3; }
        asm volatile("s_waitcnt lgkmcnt(0)" ::: "memory"); __builtin_amdgcn_s_barrier(); asm volatile("" ::: "memory");
#pragma unroll
        for (int ai = 0; ai < 2; ++ai) {
            const int blk = 2 * ai + wr;
            f32x4 l14 = {0.f, 0.f, 0.f, 0.f}, l15 = {0.f, 0.f, 0.f, 0.f};
            if (blk > 0) { const f32x4 rm2 = *(const PG8_LAS f32x4*)(xch + ((blk - 1) * 2 + 0) * 64 + ch), rm1 = *(const PG8_LAS f32x4*)(xch + ((blk - 1) * 2 + 1) * 64 + ch);
                l15 = rm1; l14 = (fr == 0) ? rm2 : rm1; }
#pragma unroll
            for (int m = 0; m < 4; ++m) {
                const int row = row0 + ai * HALF + m * 16;
                const f32x4 b = acc[ai][0][m][0], c = acc[ai][0][m][1], uu = acc[ai][1][m][0], z = acc[ai][1][m][1];
                const f32x4 cu = c * uu; f32x4 bz, p1, p2;
#pragma unroll
                for (int j = 0; j < 4; ++j) {
                    bz[j] = b[j] * z[j] * __builtin_amdgcn_rcpf(1.f + __expf(-z[j]));
                    const float r1 = __int_as_float(__builtin_amdgcn_update_dpp(0, __float_as_int(cu[j]), 0x121, 0xf, 0xf, false));
                    const float r2 = __int_as_float(__builtin_amdgcn_update_dpp(0, __float_as_int(cu[j]), 0x122, 0xf, 0xf, false));
                    p1[j] = fr >= 1 ? r1 : l15[j];
                    p2[j] = fr >= 2 ? r2 : l14[j];
                    l15[j] = r1; l14[j] = r2;
                }
                const f32x4 y = bz * (w0 * p2 + w1 * p1 + w2 * cu);
                u32x2 wv; wv.x = cvt_pk_bf16(y[0], y[1]); wv.y = cvt_pk_bf16(y[2], y[3]);
                *(u32x2*)(Y + (size_t)row * 2048 + e0) = wv;
                if (blk == 0 && m == 0 && fr < 2) { *(f32x4*)(HA + ((size_t)u.pm * 4 + fr) * 2048 + e0) = bz; *(f32x4*)(HA + ((size_t)u.pm * 4 + 2 + fr) * 2048 + e0) = cu; }
                if (blk == 3 && m == 3 && fr >= 14) *(f32x4*)(HB + ((size_t)u.pm * 2 + (fr - 14)) * 2048 + e0) = cu;
            }
        }
        asm volatile("s_waitcnt lgkmcnt(0)" ::: "memory"); __builtin_amdgcn_s_barrier(); asm volatile("" ::: "memory");
    }
};
template <int BASE_MODE> struct EpiResid {
    static constexpr bool PERM = true, AFTER_DRAIN = false; static constexpr bool BASE_BF16 = BASE_MODE != 0;
    const void* base; bf16_t* outb; float* sumsq; const float* rs0; const float* nw0;
    __device__ __forceinline__ void operator()(const f32x4 (&acc)[2][2][4][2], const Unit& u, int wr, int wc, int fr, int fq) const {
        const int row0 = u.pm * BM + wr * 64 + fr; const int col0 = u.pn * BM + wc * 32 + 8 * fq;
        f32x4 iw[2][2];
        if (BASE_MODE == 2) {
#pragma unroll
            for (int bj = 0; bj < 2; ++bj)
#pragma unroll
                for (int n = 0; n < 2; ++n) { const f32x4 w = *(const f32x4*)(nw0 + col0 + bj * HALF + 4 * n);
#pragma unroll
                    for (int j = 0; j < 4; ++j) iw[bj][n][j] = __builtin_amdgcn_rcpf(w[j]); }
        }
#pragma unroll
        for (int ai = 0; ai < 2; ++ai) {
            f32x4 bv[4][2][2];
#pragma unroll
            for (int m = 0; m < 4; ++m)
#pragma unroll
                for (int bj = 0; bj < 2; ++bj) { const size_t o = (size_t)(row0 + ai * HALF + m * 16) * 2048 + col0 + bj * HALF;
                    if (BASE_BF16) { const u32x4 w = (BASE_MODE == 1) ? __builtin_nontemporal_load((const u32x4*)((const bf16_t*)base + o)) : *(const u32x4*)((const bf16_t*)base + o);
                        bv[m][bj][0] = (f32x4){__uint_as_float(w.x << 16), __uint_as_float(w.x & 0xffff0000u), __uint_as_float(w.y << 16), __uint_as_float(w.y & 0xffff0000u)};
                        bv[m][bj][1] = (f32x4){__uint_as_float(w.z << 16), __uint_as_float(w.z & 0xffff0000u), __uint_as_float(w.w << 16), __uint_as_float(w.w & 0xffff0000u)};
                        if (BASE_MODE == 2) { const float irs = __builtin_amdgcn_rcpf(rs0[row0 + ai * HALF + m * 16]); bv[m][bj][0] = bv[m][bj][0] * iw[bj][0] * irs; bv[m][bj][1] = bv[m][bj][1] * iw[bj][1] * irs; } }
                    else { bv[m][bj][0] = *(const f32x4*)((const float*)base + o); bv[m][bj][1] = *(const f32x4*)((const float*)base + o + 4); } }
#pragma unroll
            for (int m = 0; m < 4; ++m) {
                const int row = row0 + ai * HALF + m * 16; float s = 0.f;
#pragma unroll
                for (int bj = 0; bj < 2; ++bj) {
                    const f32x4 v0 = bv[m][bj][0] + acc[ai][bj][m][0], v1 = bv[m][bj][1] + acc[ai][bj][m][1];
                    s += ((v0[0] * v0[0] + v0[1] * v0[1]) + (v0[2] * v0[2] + v0[3] * v0[3])) + ((v1[0] * v1[0] + v1[1] * v1[1]) + (v1[2] * v1[2] + v1[3] * v1[3]));
                    u32x4 w; w.x = cvt_pk_bf16(v0[0], v0[1]); w.y = cvt_pk_bf16(v0[2], v0[3]); w.z = cvt_pk_bf16(v1[0], v1[1]); w.w = cvt_pk_bf16(v1[2], v1[3]);
                    *(u32x4*)(outb + (size_t)row * 2048 + col0 + bj * HALF) = w;
                }
                s += __shfl_xor(s, 16); s += __shfl_xor(s, 32);
                if (fq == 0) unsafeAtomicAdd(sumsq + row, s);
            }
            asm volatile("" ::: "memory");
        }
    }
};
struct EpiQKVG {
    static constexpr bool PERM = true, AFTER_DRAIN = false;
    bf16_t* QK; long dG; bf16_t* VFp; const float* sumsq1; PG8_LAS unsigned char* scr;
    __device__ __forceinline__ void operator()(const f32x4 (&acc)[2][2][4][2], const Unit& u, int wr, int wc, int fr, int fq) const {
        const int row0 = u.pm * BM + wr * 64 + fr; const int sel = u.pn < 8 ? 1 : (u.pn < 16 ? 2 : 0);
        const int col0 = (u.pn & 7) * BM + wc * 32 + 8 * fq; const float sc0 = (u.pn >= 16 && u.pn < 20) ? 0.0625f : 1.0f;
        if (sel != 1) {
            bf16_t* basep = QK + (sel >= 2 ? dG : 0L);
#pragma unroll
            for (int ai = 0; ai < 2; ++ai)
#pragma unroll
                for (int m = 0; m < 4; ++m) {
                    const int row = row0 + ai * HALF + m * 16; const float rs = rsqrtf(sumsq1[row] * (1.0f / 2048.0f) + RMS_EPS) * sc0;
                    bf16_t* rowp = basep + (size_t)row * 2048 + col0;
#pragma unroll
                    for (int bj = 0; bj < 2; ++bj) { const f32x4 v0 = acc[ai][bj][m][0] * rs, v1 = acc[ai][bj][m][1] * rs;
                        u32x4 w; w.x = cvt_pk_bf16(v0[0], v0[1]); w.y = cvt_pk_bf16(v0[2], v0[3]); w.z = cvt_pk_bf16(v1[0], v1[1]); w.w = cvt_pk_bf16(v1[2], v1[3]);
                        *(u32x4*)(rowp + bj * HALF) = w; }
                }
        } else {
            const int wid = wr * 4 + wc; PG8_LAS unsigned char* my = scr + wid * 1280;
            const int lane = fq * 16 + fr, et = lane >> 5, hh = (lane >> 4) & 1, c = lane & 15, cc = 8 * (c >> 2) + 4 * et + (c & 3);
            const int b = u.pm >> 5, h = (u.pn & 7) >> 1;
#pragma unroll
            for (int ai = 0; ai < 2; ++ai) {
                const int chunk = (4 * u.pm + 2 * ai + wr) & 127; const size_t it = (size_t)(4 * b + h) * 128 + chunk;
#pragma unroll
                for (int m = 0; m < 4; ++m) {
                    const int row = row0 + ai * HALF + m * 16; const float rs = rsqrtf(sumsq1[row] * (1.0f / 2048.0f) + RMS_EPS);
#pragma unroll
                    for (int bj = 0; bj < 2; ++bj) { const f32x4 v0 = acc[ai][bj][m][0] * rs, v1 = acc[ai][bj][m][1] * rs;
                        u32x4 w; w.x = cvt_pk_bf16(v0[0], v0[1]); w.y = cvt_pk_bf16(v0[2], v0[3]); w.z = cvt_pk_bf16(v1[0], v1[1]); w.w = cvt_pk_bf16(v1[2], v1[3]);
                        *(PG8_LAS u32x4*)(my + fr * 80 + fq * 16) = w;
                        asm volatile("s_waitcnt lgkmcnt(0)" ::: "memory");
                        unsigned short hv[8];
#pragma unroll
                        for (int jj = 0; jj < 8; ++jj) hv[jj] = *(const PG8_LAS unsigned short*)(my + (8 * hh + jj) * 80 + cc * 2);
                        u32x4 o; o.x = (unsigned)hv[0] | ((unsigned)hv[1] << 16); o.y = (unsigned)hv[2] | ((unsigned)hv[3] << 16); o.z = (unsigned)hv[4] | ((unsigned)hv[5] << 16); o.w = (unsigned)hv[6] | ((unsigned)hv[7] << 16);
                        const int ne2 = 8 * (u.pn & 1) + 4 * bj + wc, ne = 2 * ne2 + et, sblk = m >> 1, q = 2 * (m & 1) + hh;
                        __builtin_nontemporal_store(o, (u32x4*)(VFp + ((it * 64 + ne * 2 + sblk) * 64 + 16 * q + c) * 8));
                        asm volatile("s_waitcnt lgkmcnt(0)" ::: "memory");
                    }
                }
            }
        }
    }
};
template <class Epi, class Sched, bool ALIGN_EPI = false, bool SP2 = false>
__device__ __forceinline__ void gemm_phase(PG8_LAS unsigned char* lds, const Gemm g, const Sched& S, const Epi& E) {
    const int tid = threadIdx.x, wid = __builtin_amdgcn_readfirstlane(tid >> 6), lane = tid & 63, wr = wid >> 2, wc = wid & 3, fr = lane & 15, fq = lane >> 4;
    const int K = g.K, nt = K / BK;
    unsigned voffA[2], voffB[2];
#pragma unroll
    for (int i = 0; i < 2; ++i) { int R, C; stage_rc(tid * 16 + i * 8192, R, C); const int Rb = Epi::PERM ? ((R & ~31) + perm32(R & 31)) : R;
        voffA[i] = (unsigned)(R * K + C) * 2u; voffB[i] = (unsigned)(Rb * K + C) * 2u; }
    const size_t kstep = (size_t)(BK * 2);
    const size_t hstep = (size_t)HALF * K * 2;
    const size_t tstep = 2 * hstep;
    const unsigned ldsw = (unsigned)wid * 1024u;
    const int aoff = lds_byte(wr * 64 + fr, fq * 8), boff = lds_byte(wc * 32 + fr, fq * 8);
#define PG8_SA(b, h) (((b) * 2 + (h)) * HTB)
#define PG8_SB(b, h) ((4 + (b) * 2 + (h)) * HTB)
#define PG8_STAGE(bufoff, gbase, voff) do { _Pragma("unroll") for (int _i = 0; _i < 2; ++_i) \
        __builtin_amdgcn_global_load_lds((const unsigned*)((const char*)(gbase) + (voff)[_i]), (PG8_LAS unsigned*)(lds + (bufoff) + ldsw + _i * 8192), 16, 0, 0); } while (0)
#define PG8_LDA(dst, b, h) do { _Pragma("unroll") for (int m = 0; m < 4; ++m) _Pragma("unroll") for (int k = 0; k < 2; ++k) dst[m][k] = *(const PG8_LAS bf16x8*)(lds + PG8_SA(b, h) + aoff + m * 2048 + k * 1024); } while (0)
#define PG8_LDB(dst, b, h) do { _Pragma("unroll") for (int n = 0; n < 2; ++n) _Pragma("unroll") for (int k = 0; k < 2; ++k) dst[n][k] = *(const PG8_LAS bf16x8*)(lds + PG8_SB(b, h) + boff + n * 2048 + k * 1024); } while (0)
#define PG8_MMA(ai, bj, At, Bt) do { __builtin_amdgcn_s_setprio(1); _Pragma("unroll") for (int m = 0; m < 4; ++m) _Pragma("unroll") for (int n = 0; n < 2; ++n) _Pragma("unroll") for (int k = 0; k < 2; ++k) \
        acc[ai][bj][m][n] = __builtin_amdgcn_mfma_f32_16x16x32_bf16(Bt[n][k], At[m][k], acc[ai][bj][m][n], 0, 0, 0); __builtin_amdgcn_s_setprio(0); } while (0)
#define PG8_WAIT_V(n) asm volatile("s_waitcnt vmcnt(" #n ")" ::: "memory")
#define PG8_WAIT_L(n) asm volatile("s_waitcnt lgkmcnt(" #n ")" ::: "memory")
#define PG8_BAR __builtin_amdgcn_s_barrier()
#define PG8_SCHED __builtin_amdgcn_sched_barrier(0)
    Unit cur, nxt; int ui = 0;
    if (!S.next(0, cur)) return;
    f32x4 acc[2][2][4][2];
#pragma unroll
    for (int a = 0; a < 2; ++a)
#pragma unroll
        for (int b = 0; b < 2; ++b)
#pragma unroll
            for (int m = 0; m < 4; ++m)
#pragma unroll
                for (int n = 0; n < 2; ++n) acc[a][b][m][n] = (f32x4){0.f, 0.f, 0.f, 0.f};
    bf16x8 At[4][2], B0[2][2], B1[2][2];
    const char* cA = (const char*)g.A + (size_t)cur.pm * tstep; const char* cB = (const char*)g.Bt + (size_t)cur.pn * tstep;
    S.a_ready(cur);
    if constexpr (SP2) {
        PG8_STAGE(PG8_SB(0, 0), cB, voffB); PG8_STAGE(PG8_SB(0, 1), cB + hstep, voffB); PG8_STAGE(PG8_SA(0, 0), cA, voffA); PG8_STAGE(PG8_SA(0, 1), cA + hstep, voffA);
        if (wr == 1) PG8_BAR;
        PG8_WAIT_V(2); PG8_BAR;
        PG8_STAGE(PG8_SB(1, 0), cB + kstep, voffB); PG8_STAGE(PG8_SA(1, 0), cA + kstep, voffA); PG8_STAGE(PG8_SB(1, 1), cB + hstep + kstep, voffB);
        PG8_WAIT_V(6); PG8_BAR;
    } else {
        PG8_STAGE(PG8_SB(0, 0), cB, voffB); PG8_STAGE(PG8_SA(0, 0), cA, voffA); PG8_STAGE(PG8_SB(0, 1), cB + hstep, voffB); PG8_STAGE(PG8_SA(0, 1), cA + hstep, voffA);
        if (wr == 1) PG8_BAR;
        PG8_WAIT_V(4); PG8_BAR;
        PG8_STAGE(PG8_SB(1, 0), cB + kstep, voffB); PG8_STAGE(PG8_SA(1, 0), cA + kstep, voffA); PG8_STAGE(PG8_SB(1, 1), cB + hstep + kstep, voffB);
        PG8_WAIT_V(6); PG8_BAR;
    }
    for (;;) {
        const bool has_next = S.next(ui + 1, nxt);
        const char* nA = has_next ? (const char*)g.A + (size_t)nxt.pm * tstep : cA; const char* nB = has_next ? (const char*)g.Bt + (size_t)nxt.pn * tstep : cB;
        for (int t = 0; t < nt; t += 2) {
            const bool last = (t == nt - 2);
            const char* a1 = cA + (size_t)(t + 1) * kstep;
            const char* a2 = last ? nA : cA + (size_t)(t + 2) * kstep; const char* b2 = last ? nB : cB + (size_t)(t + 2) * kstep;
            const char* a3 = a2 + kstep; const char* b3 = b2 + kstep;
            if (last && has_next) S.a_ready(nxt);
            if constexpr (SP2) {
            PG8_LDB(B0, 0, 0); PG8_LDB(B1, 0, 1); PG8_SCHED; PG8_LDA(At, 0, 0); PG8_STAGE(PG8_SA(1, 1), a1 + hstep, voffA);
            PG8_WAIT_V(8); PG8_WAIT_L(0); PG8_BAR; PG8_MMA(0, 0, At, B0); PG8_MMA(0, 1, At, B1); PG8_BAR; PG8_SCHED;
            PG8_LDA(At, 0, 1); PG8_STAGE(PG8_SB(0, 0), b2, voffB); PG8_STAGE(PG8_SB(0, 1), b2 + hstep, voffB); PG8_STAGE(PG8_SA(0, 0), a2, voffA);
            PG8_WAIT_V(8); PG8_WAIT_L(0); PG8_BAR; PG8_MMA(1, 0, At, B0); PG8_MMA(1, 1, At, B1); PG8_BAR; PG8_SCHED;
            PG8_LDB(B0, 1, 0); PG8_LDB(B1, 1, 1); PG8_SCHED; PG8_LDA(At, 1, 0); PG8_STAGE(PG8_SA(0, 1), a2 + hstep, voffA);
            PG8_WAIT_V(8); PG8_WAIT_L(0); PG8_BAR; PG8_MMA(0, 0, At, B0); PG8_MMA(0, 1, At, B1); PG8_BAR; PG8_SCHED;
            PG8_LDA(At, 1, 1); PG8_STAGE(PG8_SB(1, 0), b3, voffB); PG8_STAGE(PG8_SB(1, 1), b3 + hstep, voffB); PG8_STAGE(PG8_SA(1, 0), a3, voffA);
            PG8_WAIT_V(8); PG8_WAIT_L(0); PG8_BAR; PG8_MMA(1, 0, At, B0); PG8_MMA(1, 1, At, B1); PG8_BAR; PG8_SCHED;
            } else {
            PG8_LDB(B0, 0, 0); PG8_SCHED; PG8_LDA(At, 0, 0); PG8_STAGE(PG8_SA(1, 1), a1 + hstep, voffA);
            PG8_WAIT_L(8); PG8_BAR; PG8_WAIT_L(0); PG8_MMA(0, 0, At, B0); PG8_BAR; PG8_SCHED;
            PG8_LDB(B1, 0, 1); PG8_STAGE(PG8_SB(0, 0), b2, voffB);
            PG8_BAR; PG8_WAIT_L(0); PG8_MMA(0, 1, At, B1); PG8_BAR;
            PG8_LDA(At, 0, 1); PG8_STAGE(PG8_SA(0, 0), a2, voffA);
            PG8_BAR; PG8_WAIT_L(0); PG8_MMA(1, 0, At, B0); PG8_BAR; PG8_SCHED;
            PG8_STAGE(PG8_SB(0, 1), b2 + hstep, voffB);
            PG8_WAIT_V(6); PG8_BAR; PG8_MMA(1, 1, At, B1); PG8_BAR;
            PG8_LDB(B0, 1, 0); PG8_SCHED; PG8_LDA(At, 1, 0); PG8_STAGE(PG8_SA(0, 1), a2 + hstep, voffA);
            PG8_WAIT_L(8); PG8_BAR; PG8_WAIT_L(0); PG8_MMA(0, 0, At, B0); PG8_BAR; PG8_SCHED;
            PG8_LDB(B1, 1, 1); PG8_STAGE(PG8_SB(1, 0), b3, voffB);
            PG8_BAR; PG8_WAIT_L(0); PG8_MMA(0, 1, At, B1); PG8_BAR;
            PG8_LDA(At, 1, 1); PG8_STAGE(PG8_SA(1, 0), a3, voffA);
            PG8_BAR; PG8_WAIT_L(0); PG8_MMA(1, 0, At, B0); PG8_BAR; PG8_SCHED;
            PG8_STAGE(PG8_SB(1, 1), b3 + hstep, voffB);
            PG8_WAIT_V(6); PG8_BAR; PG8_MMA(1, 1, At, B1); PG8_BAR;
            }
        }
        if constexpr (ALIGN_EPI) { if (wr == 0) PG8_BAR; }
        if constexpr (!Epi::AFTER_DRAIN) { E(acc, cur, wr, wc, fr, fq); S.done(cur); }
        if (!has_next) break;
#pragma unroll
        for (int a = 0; a < 2; ++a)
#pragma unroll
            for (int b = 0; b < 2; ++b)
#pragma unroll
                for (int m = 0; m < 4; ++m)
#pragma unroll
                    for (int n = 0; n < 2; ++n) acc[a][b][m][n] = (f32x4){0.f, 0.f, 0.f, 0.f};
        cur = nxt; cA = nA; cB = nB; ++ui;
        if constexpr (ALIGN_EPI) { if (wr == 1) PG8_BAR; }
    }
    PG8_WAIT_V(0);
    if constexpr (!ALIGN_EPI) { if (wr == 0) PG8_BAR; }
    PG8_BAR;
    if constexpr (Epi::AFTER_DRAIN) { E.fused(acc, cur, wr, wc, fr, fq, lds, wid, lane); S.done(cur); }
#undef PG8_SA
#undef PG8_SB
#undef PG8_STAGE
#undef PG8_LDA
#undef PG8_LDB
#undef PG8_MMA
#undef PG8_WAIT_V
#undef PG8_WAIT_L
#undef PG8_BAR
#undef PG8_SCHED
}
}
constexpr int M = 16384, DM = 2048, TSEQ = 8192, N0 = 8192, N1 = 6144, N1RAW = 6160, NHEAD = 4, DK = 256, DV = 512, CH = 64, NCH = 128;
constexpr float EPS = 1e-6f;
constexpr int NWAVES = 8;
constexpr size_t MiB = 1u << 20;
constexpr size_t WS_CTL = 0, CTL_ZERO_BYTES = 2 * MiB;
constexpr size_t WS_SUMSQ1 = 1 * MiB, WS_SUMSQ2 = 1 * MiB + 65536, WS_HSUM = 1 * MiB + 131072;
constexpr size_t WS_GKLR = 2 * MiB;
constexpr size_t WS_EB = 3 * MiB;
constexpr size_t WS_WGT = 4 * MiB;
constexpr size_t WS_RSTD0 = 4 * MiB + 524288;
constexpr size_t WS_HA = 5 * MiB, WS_HB = 7 * MiB;
constexpr size_t WS_W0T = 8 * MiB, WS_WO0T = 40 * MiB, WS_W1T = 48 * MiB, WS_WO1T = 72 * MiB;
constexpr size_t WS_VF = 336 * MiB;
constexpr size_t WS_BUFA = 80 * MiB;
constexpr size_t WS_BUFB = 144 * MiB;
constexpr size_t WS_BUFC = 208 * MiB;
constexpr size_t WS_X1 = 272 * MiB;
constexpr size_t WS_BUFD = 400 * MiB;
constexpr size_t WS_PF = 464 * MiB;
constexpr size_t WS_DUMMY = 472 * MiB;
constexpr size_t WS_END = 473 * MiB;
constexpr int LDS_BYTES = 147456;

#define GAS __attribute__((address_space(1)))
#define LAS __attribute__((address_space(3)))
typedef unsigned short bf16;
typedef unsigned v4u __attribute__((ext_vector_type(4)));
typedef unsigned v2u __attribute__((ext_vector_type(2)));
typedef float f32x4 __attribute__((ext_vector_type(4)));
typedef float f32x2 __attribute__((ext_vector_type(2)));
typedef short bf16x8 __attribute__((ext_vector_type(8)));
#define LDS_WAIT() asm volatile("s_waitcnt lgkmcnt(0)" ::: "memory")
#define WG_BAR() do { asm volatile("s_waitcnt lgkmcnt(0)" ::: "memory"); __builtin_amdgcn_s_barrier(); asm volatile("" ::: "memory"); } while (0)
#define MFMA16(a, b, c) __builtin_amdgcn_mfma_f32_16x16x32_bf16((a), (b), (c), 0, 0, 0)
__device__ __forceinline__ unsigned pk2(float lo, float hi) { return pg8::cvt_pk_bf16(lo, hi); }
__device__ __forceinline__ unsigned f2bf_sw(float f) { const unsigned u = __float_as_uint(f); return (u + 0x7fffu + ((u >> 16) & 1u)) >> 16; }
__device__ __forceinline__ unsigned pk2_sw(float lo, float hi) { return f2bf_sw(lo) | (f2bf_sw(hi) << 16); }
__device__ __forceinline__ float bflo(unsigned u) { return __uint_as_float(u << 16); }
__device__ __forceinline__ float bfhi(unsigned u) { return __uint_as_float(u & 0xffff0000u); }
__device__ __forceinline__ float wave_sum(float v) {
#pragma unroll
    for (int o = 1; o < 64; o <<= 1) v += __shfl_xor(v, o);
    return v;
}
#define XB_TMO      128
#define XB_XCNT(j)  (256  + 64 * (j))
#define XB_XSUB(j)  (1280 + 64 * (j))
#define XB_XGEN(j)  (2304 + 64 * (j))
#define XB_TOP      3328
#define XB_TOPGEN   3392
#define XCD_BAR_WORDS 3456
#define XB_SPIN_CAP (1u << 18)

__device__ __forceinline__ unsigned xb_ld(unsigned* p)              { return __hip_atomic_load(p, __ATOMIC_RELAXED, __HIP_MEMORY_SCOPE_AGENT); }
__device__ __forceinline__ unsigned xb_add(unsigned* p, unsigned v) { return __hip_atomic_fetch_add(p, v, __ATOMIC_RELAXED, __HIP_MEMORY_SCOPE_AGENT); }
__device__ __forceinline__ unsigned xb_xcc_id() { return (unsigned)__builtin_amdgcn_s_getreg((3 << 11) | 20) & 0xFu; }
#define XB_SPIN(cond, bar) do { unsigned _sp = 0; while (cond) { __builtin_amdgcn_s_sleep(1); \
    if ((++_sp & 255u) == 0u) { if (xb_ld(&(bar)[XB_TMO])) break; if (_sp > XB_SPIN_CAP) { atomicAdd(&(bar)[XB_TMO], 1u); break; } } } } while (0)

struct XcdBarrier {
    unsigned* bar; unsigned x;
    volatile LAS unsigned* st;
};

__device__ __forceinline__ XcdBarrier xcd_barrier_post(unsigned* bar, volatile LAS unsigned* st) {
    XcdBarrier b; b.bar = bar; b.x = xb_xcc_id(); b.st = st;
    if (threadIdx.x == 0) (void)xb_add(&bar[XB_XCNT(b.x)], 1u);
    return b;
}
__device__ __forceinline__ void xcd_barrier_complete(unsigned* bar, unsigned x, unsigned& nloc, unsigned& nx) {
    const unsigned G = gridDim.x * gridDim.y * gridDim.z;
    unsigned sum, cnt, mine, sp = 0u;
    for (;;) {
        sum = 0u; cnt = 0u; mine = 0u;
#pragma unroll
        for (unsigned j = 0; j < 16; ++j) { const unsigned c = xb_ld(&bar[XB_XCNT(j)]); sum += c; cnt += (c > 0u) ? 1u : 0u; mine = (j == x) ? c : mine; }
        if (sum == G) break;
        __builtin_amdgcn_s_sleep(1);
        if ((++sp & 255u) == 0u) { if (xb_ld(&bar[XB_TMO])) break; if (sp > XB_SPIN_CAP) { atomicAdd(&bar[XB_TMO], 1u); break; } }
    }
    nloc = mine > 0u ? mine : 1u; nx = cnt > 0u ? cnt : 1u;
}

__device__ __forceinline__ void xcd_barrier(const XcdBarrier& b) {
    asm volatile("s_waitcnt vmcnt(0)" ::: "memory");
    __syncthreads();
    if (threadIdx.x == 0) {
        unsigned* bar = b.bar;
        __builtin_amdgcn_s_waitcnt(0);
        unsigned nloc = b.st[0], nx = b.st[1];
        if (nloc == 0u) { xcd_barrier_complete(bar, b.x, nloc, nx); b.st[0] = nloc; b.st[1] = nx; }
        const unsigned old = xb_add(&bar[XB_XSUB(b.x)], 1u);
        const unsigned gen = old / nloc;
        if (old + 1u == (gen + 1u) * nloc) {
            __builtin_amdgcn_fence(__ATOMIC_RELEASE, "agent");
            asm volatile("s_waitcnt vmcnt(0)" ::: "memory");
            const unsigned og = xb_add(&bar[XB_TOP], 1u);
            const unsigned tg = og / nx;
            if (og + 1u == (tg + 1u) * nx) xb_add(&bar[XB_TOPGEN], 1u);
            else XB_SPIN(xb_ld(&bar[XB_TOPGEN]) == tg, bar);
            __builtin_amdgcn_fence(__ATOMIC_ACQUIRE, "agent");
            xb_add(&bar[XB_XGEN(b.x)], 1u);
            asm volatile("s_waitcnt vmcnt(0)" ::: "memory");
        } else {
            XB_SPIN(xb_ld(&bar[XB_XGEN(b.x)]) == gen, bar);
            __builtin_amdgcn_fence(__ATOMIC_ACQUIRE, "agent");
            asm volatile("s_waitcnt vmcnt(0)" ::: "memory");
        }
    }
    __syncthreads();
}
__device__ __forceinline__ int virt0(int col) { const int g = col >> 11, e = col & 2047, pn = e >> 6, el = e & 63; return 256 * pn + 128 * (g >> 1) + 32 * (el >> 4) + 16 * (g & 1) + (el & 15); }
__device__ __forceinline__ void p0_transpose_item(const float* W, int ldw, int nblk, int K, bf16* WT, int mode, const float* rowscale, LAS float* scr, int item, int lane) {
    const int kb = item / nblk, nb = item % nblk, k0 = 64 * kb, n0 = 32 * nb;
    f32x4 wv[8]; const int kr = lane >> 3, c4 = lane & 7;
#pragma unroll
    for (int i = 0; i < 8; ++i) wv[i] = __builtin_nontemporal_load((const GAS f32x4*)(W + (size_t)(k0 + 8 * i + kr) * ldw + n0 + 4 * c4));
    if (rowscale) {
#pragma unroll
        for (int i = 0; i < 8; ++i) wv[i] = wv[i] * rowscale[k0 + 8 * i + kr];
    }
#pragma unroll
    for (int i = 0; i < 8; ++i) { LAS float* d = scr + (8 * i + kr) * 33 + 4 * c4; d[0] = wv[i].x; d[1] = wv[i].y; d[2] = wv[i].z; d[3] = wv[i].w; }
    LDS_WAIT(); asm volatile("" ::: "memory");
    const int c = lane & 7;
#pragma unroll
    for (int j = 0; j < 4; ++j) { const int n = (lane >> 3) + 8 * j; const LAS float* s = scr + (8 * c) * 33 + n;
        v4u o; o.x = pk2(s[0 * 33], s[1 * 33]); o.y = pk2(s[2 * 33], s[3 * 33]); o.z = pk2(s[4 * 33], s[5 * 33]); o.w = pk2(s[6 * 33], s[7 * 33]);
        const int nn = n0 + n; const int dst = mode == 1 ? virt0(nn) : (mode == 2 ? (nn + 4096) % 6144 : nn);
        *(GAS v4u*)(WT + (size_t)dst * K + k0 + 8 * c) = o; }
    LDS_WAIT(); asm volatile("" ::: "memory");
}
__device__ __forceinline__ void rms_rows2_to_bf16(const float* xrow0, const float* xrow1, const float* w, bf16* orow0, bf16* orow1, float* rs0, float* rs1, int lane) {
    const GAS f32x4* xr0 = (const GAS f32x4*)xrow0 + lane; const GAS f32x4* xr1 = (const GAS f32x4*)xrow1 + lane; const GAS f32x4* wr = (const GAS f32x4*)w + lane;
    f32x4 v0[8], v1[8]; float s0 = 0.f, s1 = 0.f;
#pragma unroll
    for (int j = 0; j < 8; ++j) { v0[j] = __builtin_nontemporal_load(xr0 + 64 * j); v1[j] = __builtin_nontemporal_load(xr1 + 64 * j); }
#pragma unroll
    for (int j = 0; j < 8; ++j) { s0 += (v0[j].x * v0[j].x + v0[j].y * v0[j].y) + (v0[j].z * v0[j].z + v0[j].w * v0[j].w); s1 += (v1[j].x * v1[j].x + v1[j].y * v1[j].y) + (v1[j].z * v1[j].z + v1[j].w * v1[j].w); }
    const float r0 = rsqrtf(wave_sum(s0) * (1.f / DM) + EPS), r1 = rsqrtf(wave_sum(s1) * (1.f / DM) + EPS);
    if (lane == 0) { *rs0 = r0; *rs1 = r1; }
    GAS v2u* o0 = (GAS v2u*)orow0 + lane; GAS v2u* o1 = (GAS v2u*)orow1 + lane;
#pragma unroll
    for (int j = 0; j < 8; ++j) { const f32x4 ww = wr[64 * j]; v2u a, b;
        a.x = pk2(v0[j].x * r0 * ww.x, v0[j].y * r0 * ww.y); a.y = pk2(v0[j].z * r0 * ww.z, v0[j].w * r0 * ww.w); o0[64 * j] = a;
        b.x = pk2(v1[j].x * r1 * ww.x, v1[j].y * r1 * ww.y); b.y = pk2(v1[j].z * r1 * ww.z, v1[j].w * r1 * ww.w); o1[64 * j] = b; }
}

__device__ __forceinline__ void unpack8(const v4u x, float (&f)[8]) { f[0] = bflo(x.x); f[1] = bfhi(x.x); f[2] = bflo(x.y); f[3] = bfhi(x.y); f[4] = bflo(x.z); f[5] = bfhi(x.z); f[6] = bflo(x.w); f[7] = bfhi(x.w); }
__device__ __forceinline__ void conv_fix_panel(const float* HA, const float* HB, const float* wconv, bf16* Y, int pm, int tid) {
    if ((pm & 31) == 0) return;
    const int e0 = tid * 4;
    const f32x4 bz0 = *(const GAS f32x4*)(HA + ((size_t)pm * 4 + 0) * 2048 + e0), bz1 = *(const GAS f32x4*)(HA + ((size_t)pm * 4 + 1) * 2048 + e0);
    const f32x4 cu0 = *(const GAS f32x4*)(HA + ((size_t)pm * 4 + 2) * 2048 + e0), cu1 = *(const GAS f32x4*)(HA + ((size_t)pm * 4 + 3) * 2048 + e0);
    const f32x4 cm2 = *(const GAS f32x4*)(HB + ((size_t)(pm - 1) * 2 + 0) * 2048 + e0), cm1 = *(const GAS f32x4*)(HB + ((size_t)(pm - 1) * 2 + 1) * 2048 + e0);
    f32x4 w0, w1, w2;
#pragma unroll
    for (int j = 0; j < 4; ++j) { w0[j] = wconv[(e0 + j) * 3 + 0]; w1[j] = wconv[(e0 + j) * 3 + 1]; w2[j] = wconv[(e0 + j) * 3 + 2]; }
    const f32x4 y0 = bz0 * (w0 * cm2 + w1 * cm1 + w2 * cu0), y1 = bz1 * (w0 * cm1 + w1 * cu0 + w2 * cu1);
    *(GAS v2u*)(Y + (size_t)(pm * 256) * 2048 + e0) = (v2u){pk2(y0[0], y0[1]), pk2(y0[2], y0[3])};
    *(GAS v2u*)(Y + (size_t)(pm * 256 + 1) * 2048 + e0) = (v2u){pk2(y1[0], y1[1]), pk2(y1[2], y1[3])};
}

__device__ __forceinline__ void gklr_phase(LAS unsigned char* lds, const bf16* X1B, const bf16* WGT, const float* sumsq1, float* GKLR, int G, int rg0, int wave, int lane) {
    const int r = lane & 15, q = lane >> 4, kh = wave & 1;
    for (int rg = rg0 + (wave >> 1); rg - (wave >> 1) < M / 16; rg += G * 4) {
        const int row0 = rg * 16; const bool live = rg < M / 16;
        f32x4 acc = {0.f, 0.f, 0.f, 0.f};
        if (live) {
            const GAS bf16x8* ap = (const GAS bf16x8*)(X1B + (size_t)(row0 + r) * 2048 + 1024 * kh + 8 * q);
            const GAS bf16x8* bp = (const GAS bf16x8*)(WGT + (size_t)r * 2048 + 1024 * kh + 8 * q);
#pragma unroll 8
            for (int s = 0; s < 32; ++s) acc = MFMA16(ap[4 * s], bp[4 * s], acc);
        }
        if (kh) *(LAS f32x4*)(lds + ((wave >> 1) * 64 + lane) * 16) = acc;
        WG_BAR();
        if (!kh && live) { acc = acc + *(const LAS f32x4*)(lds + ((wave >> 1) * 64 + lane) * 16);
#pragma unroll
            for (int j = 0; j < 4; ++j) { const int row = row0 + 4 * q + j; GKLR[(size_t)row * 16 + r] = acc[j] * rsqrtf(sumsq1[row] * (1.f / DM) + EPS); } }
        WG_BAR();
    }
}

constexpr int P5_QS = 0, P5_KS = 33792, P5_KST = 67584, P5_PS = 104448, P5_GLR = 113664, P5_TOT = 117760;
__device__ __forceinline__ float logsig(float x) { return fminf(x, 0.f) - __logf(1.f + __expf(-fabsf(x))); }
__device__ __forceinline__ void gate_phase(LAS unsigned char* lds, const bf16* QK, const bf16* V, const float* GKLR, const float* wgk2, const float* bgk2,
                                           bf16* QF, bf16* KF, bf16* PF, bf16* VF, float* EB, int G, int vid, int qpm, int tid, int wave, int lane) {
    const int r = lane & 15, q = lane >> 4;
#define P5_ITEM(ITEM0) (qpm >= 0 ? ((4 * (qpm & 31) + 3 - ((ITEM0) >> 8)) << 3) | (4 * (qpm >> 5) + (vid >> 6)) : ((1023 - (ITEM0)) ^ 7))
    unsigned qx[16], kx[16]; float wA[16], wB[16]; f32x2 bias = {0.f, 0.f}; int hprev = -1;
    const int dp = tid & 127, tq = tid >> 7, d0 = 2 * dp;
#define P5_FETCH(ITEM0) do { const int item_ = P5_ITEM(ITEM0); const int bh_ = item_ & 7, c_ = item_ >> 3; const int rb_ = (bh_ >> 2) * TSEQ + c_ * CH, kc_ = (bh_ & 3) * DK + d0; \
        _Pragma("unroll") for (int i = 0; i < 16; ++i) { const size_t ro = (size_t)(rb_ + 16 * tq + i) * 2048 + kc_; \
            qx[i] = __builtin_nontemporal_load((const GAS unsigned*)(QK + ro)); kx[i] = __builtin_nontemporal_load((const GAS unsigned*)(QK + ro + 1024)); } } while (0)
    if (vid < 1024) P5_FETCH(vid);
    for (int item0 = vid; item0 < 1024; item0 += G) {
        const int item = P5_ITEM(item0);
        const int bh = item & 7, c = item >> 3, b = bh >> 2, h = bh & 3; const size_t it = (size_t)bh * NCH + c; const int rowbase = b * TSEQ + c * CH;
        if (tid < 256) { const int t = tid >> 2, r4 = tid & 3; *(LAS f32x4*)(lds + P5_GLR + t * 64 + r4 * 16) = *(const GAS f32x4*)(GKLR + (size_t)(rowbase + t) * 16 + 4 * r4); }
        const int kc = h * DK + d0;
        if (h != hprev) {
#pragma unroll
            for (int rr = 0; rr < 16; ++rr) { const f32x2 w = *(const GAS f32x2*)(wgk2 + rr * 1024 + kc); wA[rr] = w.x; wB[rr] = w.y; }
            bias = *(const GAS f32x2*)(bgk2 + kc); hprev = h; }
        WG_BAR();
        float blA[16], blB[16]; float cumA = 0.f, cumB = 0.f;
#pragma unroll
        for (int i = 0; i < 16; ++i) { const LAS f32x4* gp = (const LAS f32x4*)(lds + P5_GLR + (16 * tq + i) * 64);
            float la = bias.x, lb = bias.y;
#pragma unroll
            for (int r4 = 0; r4 < 4; ++r4) { const f32x4 g = gp[r4];
                la += g.x * wA[4 * r4] + g.y * wA[4 * r4 + 1] + g.z * wA[4 * r4 + 2] + g.w * wA[4 * r4 + 3];
                lb += g.x * wB[4 * r4] + g.y * wB[4 * r4 + 1] + g.z * wB[4 * r4 + 2] + g.w * wB[4 * r4 + 3]; }
            cumA += logsig(la) * 0.0625f; cumB += logsig(lb) * 0.0625f; blA[i] = cumA; blB[i] = cumB; }
        *(LAS f32x2*)(lds + P5_TOT + (tq * 256 + d0) * 4) = (f32x2){cumA, cumB};
        WG_BAR();
        float offA = 0.f, offB = 0.f, lastA = 0.f, lastB = 0.f;
#pragma unroll
        for (int k = 0; k < 4; ++k) { const f32x2 tt = *(const LAS f32x2*)(lds + P5_TOT + (k * 256 + d0) * 4); if (k < tq) { offA += tt.x; offB += tt.y; } lastA += tt.x; lastB += tt.y; }
        if (tq == 0) *(GAS f32x2*)(EB + it * 256 + d0) = (f32x2){__expf(lastA), __expf(lastB)};
        unsigned kw[16];
#pragma unroll
        for (int i = 0; i < 16; ++i) { const int t = 16 * tq + i; const float bA = offA + blA[i], bB = offB + blB[i];
            const float eA = __expf(bA), eB = __expf(bB), nA = __expf(-bA), nB = __expf(-bB);
            *(LAS unsigned*)(lds + P5_QS + t * 528 + d0 * 2) = pk2(bflo(qx[i]) * eA, bfhi(qx[i]) * eB);
            kw[i] = pk2(bflo(kx[i]) * nA, bfhi(kx[i]) * nB);
            *(LAS unsigned*)(lds + P5_KS + t * 528 + d0 * 2) = kw[i]; }
        if (item0 + G < 1024) P5_FETCH(item0 + G);
#pragma unroll
        for (int g = 0; g < 2; ++g) { v4u lo, hi;
#pragma unroll
            for (int k = 0; k < 4; ++k) { const unsigned a = kw[8 * g + 2 * k], bb = kw[8 * g + 2 * k + 1]; lo[k] = (a & 0xffffu) | (bb << 16); hi[k] = (a >> 16) | (bb & 0xffff0000u); }
            *(LAS v4u*)(lds + P5_KST + d0 * 144 + (16 * tq + 8 * g) * 2) = lo; *(LAS v4u*)(lds + P5_KST + (d0 + 1) * 144 + (16 * tq + 8 * g) * 2) = hi; }
        WG_BAR();
#pragma unroll
        for (int k = 0; k < 2; ++k) { const int tl = 2 * wave + k, mt = tl >> 2, nt = tl & 3; f32x4 acc = {0.f, 0.f, 0.f, 0.f};
            if (nt <= mt) {
#pragma unroll
                for (int s = 0; s < 8; ++s) { const bf16x8 qf = *(const LAS bf16x8*)(lds + P5_QS + (16 * mt + r) * 528 + (32 * s + 8 * q) * 2);
                    const bf16x8 kf = *(const LAS bf16x8*)(lds + P5_KS + (16 * nt + r) * 528 + (32 * s + 8 * q) * 2);
                    acc = MFMA16(kf, qf, acc); }
            }
            const int i_ = 16 * mt + r, j0 = 16 * nt + 4 * q; float p[4];
#pragma unroll
            for (int jj = 0; jj < 4; ++jj) p[jj] = (j0 + jj <= i_) ? acc[jj] : 0.f;
            *(LAS v2u*)(lds + P5_PS + i_ * 144 + j0 * 2) = (v2u){pk2(p[0], p[1]), pk2(p[2], p[3])}; }
#pragma unroll
        for (int i = 0; i < 4; ++i) { const int blk = wave * 4 + i, mt = blk >> 3, s = blk & 7;
            const v4u f = *(const LAS v4u*)(lds + P5_QS + (16 * mt + r) * 528 + (32 * s + 8 * q) * 2);
            *(GAS v4u*)(QF + (it * 32 + blk) * 512 + lane * 8) = f; }
#pragma unroll
        for (int i = 0; i < 4; ++i) { const int blk = wave * 4 + i, md = blk >> 1, s = blk & 1;
            const v4u f = *(const LAS v4u*)(lds + P5_KST + (16 * md + r) * 144 + (32 * s + 8 * q) * 2);
            *(GAS v4u*)(KF + (it * 32 + blk) * 512 + lane * 8) = f; }
        WG_BAR();
        { const int mt = wave >> 1, s = wave & 1;
          const v4u f = *(const LAS v4u*)(lds + P5_PS + (16 * mt + r) * 144 + (32 * s + 8 * q) * 2);
          *(GAS v4u*)(PF + (it * 8 + wave) * 512 + lane * 8) = f; }
        WG_BAR();
    }
}

struct ULd { bf16x8 vfn; bf16x8 kf[2][2]; f32x4 eb[2]; };
struct OLd { bf16x8 qf[4]; bf16x8 pf; };
__device__ __forceinline__ void u_load(ULd& L, const bf16* KF, const bf16* VF, const float* EB, size_t it, int ne2, int dh, int w, int lane) {
    L.vfn = __builtin_nontemporal_load((const GAS bf16x8*)(VF + (it * 64 + ne2 * 4 + w) * 512) + lane);
    const GAS bf16x8* kp = (const GAS bf16x8*)(KF + (it * 32 + 16 * dh + 4 * w) * 512) + lane;
#pragma unroll
    for (int i = 0; i < 2; ++i)
#pragma unroll
        for (int s = 0; s < 2; ++s) L.kf[i][s] = kp[(2 * i + s) * 64];
    const GAS f32x4* ep = (const GAS f32x4*)(EB + it * 256 + 128 * dh + 32 * w + 4 * (lane >> 4));
#pragma unroll
    for (int i = 0; i < 2; ++i) L.eb[i] = ep[4 * i];
}
__device__ __forceinline__ void o_load(OLd& L, const bf16* QF, const bf16* PF, size_t it, int dh, int mt, int lane) {
    const GAS bf16x8* qp = (const GAS bf16x8*)(QF + (it * 32 + 8 * mt + 4 * dh) * 512) + lane;
#pragma unroll
    for (int s = 0; s < 4; ++s) L.qf[s] = qp[s * 64];
    L.pf = *((const GAS bf16x8*)(PF + (it * 8 + 2 * mt + dh) * 512) + lane);
}
constexpr int SB_STRIDE = 272, SB_BYTES = 32 * SB_STRIDE;
constexpr int VFB_OFF = 2 * SB_BYTES, VFB_BYTES = 4096;
__device__ __forceinline__ void u_step(const ULd& L, const ULd& Ln, f32x4 (&S)[2][2], LAS unsigned char* sb_nxt, const LAS unsigned char* vfb_cur, LAS unsigned char* vfb_nxt, int w, int lane) {
    const int c = lane & 15, q = lane >> 4;
    bf16x8 vf[2][2];
#pragma unroll
    for (int et = 0; et < 2; ++et)
#pragma unroll
        for (int s = 0; s < 2; ++s) vf[et][s] = *(const LAS bf16x8*)(vfb_cur + ((2 * et + s) * 64 + lane) * 16);
    *(LAS bf16x8*)(vfb_nxt + (w * 64 + lane) * 16) = Ln.vfn;
#pragma unroll
    for (int i = 0; i < 2; ++i)
#pragma unroll
        for (int et = 0; et < 2; ++et) {
            S[et][i] = MFMA16(L.kf[i][0], vf[et][0], S[et][i]); S[et][i] = MFMA16(L.kf[i][1], vf[et][1], S[et][i]);
        }
#pragma unroll
    for (int i = 0; i < 2; ++i)
#pragma unroll
        for (int et = 0; et < 2; ++et) {
            S[et][i] = S[et][i] * L.eb[i];
            *(LAS v2u*)(sb_nxt + (16 * et + c) * SB_STRIDE + (32 * w + 16 * i + 4 * q) * 2) = (v2u){pk2(S[et][i][0], S[et][i][1]), pk2(S[et][i][2], S[et][i][3])};
        }
    WG_BAR();
}
__device__ __forceinline__ void o_step(const OLd& L, const LAS unsigned char* sb_cur, const LAS unsigned char* vfb_cur, bf16* O, int row0, int col0, int dh, int lane) {
    const int c = lane & 15, q = lane >> 4;
    f32x4 acc[2];
    acc[0] = (f32x4){0.f, 0.f, 0.f, 0.f}; acc[1] = acc[0];
#pragma unroll
    for (int s = 0; s < 4; ++s)
#pragma unroll
        for (int et = 0; et < 2; ++et) { const bf16x8 sf = *(const LAS bf16x8*)(sb_cur + (16 * et + c) * SB_STRIDE + (32 * s + 8 * q) * 2); acc[et] = MFMA16(sf, L.qf[s], acc[et]); }
#pragma unroll
    for (int et = 0; et < 2; ++et) { const bf16x8 vf = *(const LAS bf16x8*)(vfb_cur + ((2 * et + dh) * 64 + lane) * 16); acc[et] = MFMA16(vf, L.pf, acc[et]); }
    const int row = row0 + c;
    v4u w;
    asm volatile("s_nop 7\n\ts_nop 3\n\tv_cvt_pk_bf16_f32 %0, %4, %5\n\tv_cvt_pk_bf16_f32 %1, %6, %7\n\tv_cvt_pk_bf16_f32 %2, %8, %9\n\tv_cvt_pk_bf16_f32 %3, %10, %11"
                 : "=&v"(w.x), "=&v"(w.y), "=&v"(w.z), "=&v"(w.w)
                 : "v"(acc[0][0]), "v"(acc[0][1]), "v"(acc[0][2]), "v"(acc[0][3]), "v"(acc[1][0]), "v"(acc[1][1]), "v"(acc[1][2]), "v"(acc[1][3]));
    *(GAS v4u*)(O + (size_t)row * 2048 + col0 + 8 * q) = w;
    WG_BAR();
}
__device__ __forceinline__ void scan_phase(LAS unsigned char* lds, const bf16* QF, const bf16* KF, const bf16* PF, const bf16* VF, const float* EB, bf16* O0, bf16* O1, int G, int vid, int tid, int wave, int lane) {
    for (int item = vid; item < 256; item += G) {
        const int bh = item & 7, dh = (item >> 3) & 1, ne2 = item >> 4, b = bh >> 2, h = bh & 3; const size_t it0 = (size_t)bh * NCH;
        for (int i = tid; i < 2 * SB_BYTES / 4; i += 512) ((LAS unsigned*)lds)[i] = 0u;
        LAS unsigned char* vfb = lds + VFB_OFF;
        if (wave < 4) {
            f32x4 S[2][2];
#pragma unroll
            for (int et = 0; et < 2; ++et)
#pragma unroll
                for (int i = 0; i < 2; ++i) S[et][i] = (f32x4){0.f, 0.f, 0.f, 0.f};
            ULd A, B, C; u_load(A, KF, VF, EB, it0, ne2, dh, wave, lane); u_load(B, KF, VF, EB, it0 + 1, ne2, dh, wave, lane);
            *(LAS bf16x8*)(vfb + (wave * 64 + lane) * 16) = A.vfn;
            WG_BAR();
            int c = 0;
            for (; c < NCH - 2; c += 3) {
                u_load(C, KF, VF, EB, it0 + c + 2, ne2, dh, wave, lane);
                u_step(A, B, S, lds + ((c + 1) & 1) * SB_BYTES, vfb + (c & 1) * VFB_BYTES, vfb + ((c + 1) & 1) * VFB_BYTES, wave, lane);
                u_load(A, KF, VF, EB, it0 + c + 3, ne2, dh, wave, lane);
                u_step(B, C, S, lds + (c & 1) * SB_BYTES, vfb + ((c + 1) & 1) * VFB_BYTES, vfb + (c & 1) * VFB_BYTES, wave, lane);
                u_load(B, KF, VF, EB, it0 + (c + 4 < NCH ? c + 4 : NCH - 1), ne2, dh, wave, lane);
                u_step(C, A, S, lds + ((c + 1) & 1) * SB_BYTES, vfb + (c & 1) * VFB_BYTES, vfb + ((c + 1) & 1) * VFB_BYTES, wave, lane);
            }
            u_step(A, B, S, lds + ((c + 1) & 1) * SB_BYTES, vfb + (c & 1) * VFB_BYTES, vfb + ((c + 1) & 1) * VFB_BYTES, wave, lane);
            u_step(B, B, S, lds + (c & 1) * SB_BYTES, vfb + ((c + 1) & 1) * VFB_BYTES, vfb + (c & 1) * VFB_BYTES, wave, lane);
        } else {
            const int mt = wave - 4, col0 = h * DV + 32 * ne2, rb = b * TSEQ + 16 * mt; bf16* O = dh ? O1 : O0;
            OLd A, B, C; o_load(A, QF, PF, it0, dh, mt, lane); o_load(B, QF, PF, it0 + 1, dh, mt, lane);
            WG_BAR();
            int c = 0;
            for (; c < NCH - 2; c += 3) {
                o_load(C, QF, PF, it0 + c + 2, dh, mt, lane);
                o_step(A, lds + (c & 1) * SB_BYTES, vfb + (c & 1) * VFB_BYTES, O, rb + c * CH, col0, dh, lane);
                o_load(A, QF, PF, it0 + c + 3, dh, mt, lane);
                o_step(B, lds + ((c + 1) & 1) * SB_BYTES, vfb + ((c + 1) & 1) * VFB_BYTES, O, rb + (c + 1) * CH, col0, dh, lane);
                o_load(B, QF, PF, it0 + (c + 4 < NCH ? c + 4 : NCH - 1), dh, mt, lane);
                o_step(C, lds + (c & 1) * SB_BYTES, vfb + (c & 1) * VFB_BYTES, O, rb + (c + 2) * CH, col0, dh, lane);
            }
            o_step(A, lds + (c & 1) * SB_BYTES, vfb + (c & 1) * VFB_BYTES, O, rb + c * CH, col0, dh, lane);
            o_step(B, lds + ((c + 1) & 1) * SB_BYTES, vfb + ((c + 1) & 1) * VFB_BYTES, O, rb + (c + 1) * CH, col0, dh, lane);
        }
        WG_BAR();
    }
}

__device__ __forceinline__ void outgate_phase(bf16* O, const bf16* O1, const bf16* Gt, const float* gnw, int gw, int NGW, int lane) {
    const f32x4 w0 = *(const GAS f32x4*)(gnw + lane * 8), w1 = *(const GAS f32x4*)(gnw + lane * 8 + 4);
    const float w[8] = {w0.x, w0.y, w0.z, w0.w, w1.x, w1.y, w1.z, w1.w};
    for (int m = gw; m < M / 2; m += NGW) {
        v4u ov[2][4], pv[2][4], gv[2][4];
#pragma unroll
        for (int rr = 0; rr < 2; ++rr)
#pragma unroll
            for (int j = 0; j < 4; ++j) { const size_t off = (size_t)(m + rr * (M / 2)) * 2048 + 512 * j + 8 * lane; ov[rr][j] = *(const GAS v4u*)(O + off); pv[rr][j] = *(const GAS v4u*)(O1 + off); gv[rr][j] = __builtin_nontemporal_load((const GAS v4u*)(Gt + off)); }
#pragma unroll
        for (int rr = 0; rr < 2; ++rr)
#pragma unroll
            for (int j = 0; j < 4; ++j) {
                float o[8], o1[8], g[8], y[8]; unpack8(ov[rr][j], o); unpack8(pv[rr][j], o1); unpack8(gv[rr][j], g);
#pragma unroll
                for (int i = 0; i < 8; ++i) o[i] += o1[i];
                float ss = 0.f;
#pragma unroll
                for (int i = 0; i < 8; ++i) ss += o[i] * o[i];
                const float rs = rsqrtf(wave_sum(ss) * (1.f / DV) + EPS);
#pragma unroll
                for (int i = 0; i < 8; ++i) y[i] = o[i] * rs * w[i] * g[i] * __builtin_amdgcn_rcpf(1.f + __expf(-g[i]));
                v4u r; r.x = pk2(y[0], y[1]); r.y = pk2(y[2], y[3]); r.z = pk2(y[4], y[5]); r.w = pk2(y[6], y[7]);
                *(GAS v4u*)(O + (size_t)(m + rr * (M / 2)) * 2048 + 512 * j + 8 * lane) = r;
            }
    }
}
__device__ __forceinline__ void final_norm_phase(const bf16* X2, float* out, const float* sumsq2, const float* w, int gt, int NT) {
    const f32x4 wa = *(const GAS f32x4*)(w + (gt & 255) * 8), wb = *(const GAS f32x4*)(w + (gt & 255) * 8 + 4);
    for (int p0 = gt; p0 < M * 256; p0 += 8 * NT) {
        v4u xv[8]; float ss[8];
#pragma unroll
        for (int k = 0; k < 8; ++k) { const int p = p0 + k * NT; if (p < M * 256) { xv[k] = __builtin_nontemporal_load((const GAS v4u*)(X2 + (size_t)p * 8)); ss[k] = sumsq2[p >> 8]; } }
#pragma unroll
        for (int k = 0; k < 8; ++k) { const int p = p0 + k * NT; if (p < M * 256) { const float rs = rsqrtf(ss[k] * (1.f / DM) + EPS); float x[8]; unpack8(xv[k], x);
            *(GAS f32x4*)(out + (size_t)p * 8) = (f32x4){x[0] * rs * wa.x, x[1] * rs * wa.y, x[2] * rs * wa.z, x[3] * rs * wa.w};
            *(GAS f32x4*)(out + (size_t)p * 8 + 4) = (f32x4){x[4] * rs * wb.x, x[5] * rs * wb.y, x[6] * rs * wb.z, x[7] * rs * wb.w}; } }
    }
}
#ifndef REP_P0
#define REP_P0 1
#endif
#ifndef REP_P1
#define REP_P1 1
#endif
#ifndef REP_P2
#define REP_P2 1
#endif
#ifndef REP_P5
#define REP_P5 1
#endif
#ifndef REP_P6
#define REP_P6 1
#endif
#ifndef REP_P4
#define REP_P4 1
#endif
#ifndef USE_XCD_BAR
#define USE_XCD_BAR 1
#endif
struct Args { const float* in[12]; float* out; unsigned char* ws; };
__global__ void __launch_bounds__(NWAVES * 64, 2) hybrid_fwd(Args a) {
    extern __shared__ __attribute__((aligned(16))) unsigned char lds_raw[];
    LAS unsigned char* lds = (LAS unsigned char*)lds_raw;
    cg::grid_group grid = cg::this_grid();
    const int tid = threadIdx.x, lane = tid & 63, wave = __builtin_amdgcn_readfirstlane(tid >> 6);
    const int G = gridDim.x, gw = blockIdx.x * NWAVES + wave, NGW = G * NWAVES, gt = blockIdx.x * (NWAVES * 64) + tid, NT = G * NWAVES * 64;
    unsigned char* ws = a.ws;
    const float* x = a.in[0]; const float* norm0_w = a.in[1]; const float* w_in0 = a.in[2]; const float* w_conv = a.in[3]; const float* w_out0 = a.in[4];
    const float* norm1_w = a.in[5]; const float* w_in1 = a.in[6]; const float* w_gk2 = a.in[7]; const float* b_gk2 = a.in[8]; const float* gn_w = a.in[9]; const float* w_out1 = a.in[10]; const float* normf_w = a.in[11];
    float* sumsq1 = (float*)(ws + WS_SUMSQ1); float* sumsq2 = (float*)(ws + WS_SUMSQ2); float* hsum = (float*)(ws + WS_HSUM);
    float* rstd0 = (float*)(ws + WS_RSTD0); float* gklr = (float*)(ws + WS_GKLR); float* eb = (float*)(ws + WS_EB);
    bf16* wgt = (bf16*)(ws + WS_WGT); bf16* w0t = (bf16*)(ws + WS_W0T); bf16* wo0t = (bf16*)(ws + WS_WO0T); bf16* w1t = (bf16*)(ws + WS_W1T); bf16* wo1t = (bf16*)(ws + WS_WO1T);
    bf16* bufA = (bf16*)(ws + WS_BUFA); bf16* bufB = (bf16*)(ws + WS_BUFB); bf16* bufC = (bf16*)(ws + WS_BUFC); bf16* bufD = (bf16*)(ws + WS_BUFD);
    bf16* x1b = (bf16*)(ws + WS_X1);
    bf16* vf = (bf16*)(ws + WS_VF); bf16* qf = bufC; bf16* kf = bufC + (size_t)16 * 1024 * 1024; bf16* pf = (bf16*)(ws + WS_PF);
#if USE_XCD_BAR
    volatile LAS unsigned* misc = (volatile LAS unsigned*)(lds + LDS_BYTES - 64);
    unsigned* ctlw = (unsigned*)(ws + WS_CTL);
    constexpr int CW_PROG = 8192;
    constexpr int CW_XQID = 12288, CW_BAD = 12800, CW_QCNT = 16384;
    if (tid == 0) { misc[0] = 0u; misc[1] = 0u; __hip_atomic_store(ctlw + CW_XQID + blockIdx.x, xb_xcc_id() + 1u, __ATOMIC_RELAXED, __HIP_MEMORY_SCOPE_AGENT); }
    __syncthreads();
    XcdBarrier xbar = xcd_barrier_post((unsigned*)(ws + WS_CTL) + 1024, (volatile LAS unsigned*)(lds + LDS_BYTES - 64));
    if (a.ws == nullptr) grid.sync();
#define GRID_BAR() xcd_barrier(xbar)
#else
#define GRID_BAR() grid.sync()
#endif

    for (int rep = 0; rep < REP_P0; ++rep) {
        LAS float* scr = (LAS float*)(lds + wave * 16384);
        constexpr int I0 = 32 * 256, IO = 32 * 64, I1 = 32 * 192, NITEMS = I0 + IO + I1 + IO;
        for (int it = gw; it < NITEMS; it += NGW) {
            int r = it;
            if (r < IO) { p0_transpose_item(w_out1, DM, 64, DM, wo1t, 0, nullptr, scr, r, lane); continue; } r -= IO;
            if (r < I1) { p0_transpose_item(w_in1, N1RAW, 192, DM, w1t, 2, norm1_w, scr, r, lane); continue; } r -= I1;
            if (r < IO) { p0_transpose_item(w_out0, DM, 64, DM, wo0t, 0, nullptr, scr, r, lane); continue; } r -= IO;
            p0_transpose_item(w_in0, N0, 256, DM, w0t, 1, nullptr, scr, r, lane);
        }
        for (int p = gt; p < 16 * DM; p += NT) { const int n = p >> 11, k = p & (DM - 1); wgt[p] = (bf16)(pk2(w_in1[(size_t)k * N1RAW + N1 + n] * norm1_w[k], 0.f) & 0xffffu); }
        for (int m = gw; m < M / 2; m += NGW) rms_rows2_to_bf16(x + (size_t)m * DM, x + (size_t)(m + M / 2) * DM, norm0_w, bufA + (size_t)m * DM, bufA + (size_t)(m + M / 2) * DM, rstd0 + m, rstd0 + m + M / 2, lane);
    }
    GRID_BAR();
    const int vid = (int)blockIdx.x;
    if (tid == 0) { bool ok = (G == 256);
        if (ok) { const unsigned a0 = xb_ld(ctlw + CW_XQID + (vid & 63)), a1 = xb_ld(ctlw + CW_XQID + (vid & 63) + 64), a2 = xb_ld(ctlw + CW_XQID + (vid & 63) + 128), a3 = xb_ld(ctlw + CW_XQID + (vid & 63) + 192);
                  ok = (a0 != 0u) && a0 == a1 && a1 == a2 && a2 == a3; }
        if (!ok) xb_add(ctlw + CW_BAD, 1u); }
    for (int rep = 0; rep < REP_P1; ++rep) {
        pg8::Gemm g{bufA, w0t, M, N0, DM}; pg8::StaticOrder S; S.init(M, N0, G, vid);
        pg8::EpiConvFused E{bufB, w_conv, (float*)(ws + WS_HA), (float*)(ws + WS_HB), (LAS float*)(lds + 131072)};
        pg8::gemm_phase<pg8::EpiConvFused, pg8::StaticOrder, true, true>(lds, g, S, E);
    }
    GRID_BAR();
    if (tid == 0) misc[5] = (xb_ld(ctlw + CW_BAD) == 0u) ? 1u : 0u;
    __syncthreads();
    const bool quadmode = __builtin_amdgcn_readfirstlane((int)misc[5]) != 0;
    unsigned* qcnt = ctlw + CW_QCNT + 64 * (vid & 63); unsigned qgen = 0u;
    int qpm = -1; if (quadmode) { pg8::StaticOrder S; S.init(M, DM, G, vid); pg8::Unit u0; (void)S.next(0, u0); qpm = u0.pm; }
#define QUAD_OR_GRID_BAR() do { if (quadmode) { \
        asm volatile("s_waitcnt vmcnt(0)" ::: "memory"); __syncthreads(); \
        if (tid == 0) { (void)xb_add(qcnt, 1u); const unsigned want_ = 4u * (qgen + 1u); unsigned sp_ = 0u; \
            while (xb_ld(qcnt) < want_) { __builtin_amdgcn_s_sleep(1); if (++sp_ > (1u << 22)) break; } \
            __builtin_amdgcn_fence(__ATOMIC_ACQUIRE, "agent"); asm volatile("s_waitcnt vmcnt(0)" ::: "memory"); } \
        ++qgen; __syncthreads(); } else { GRID_BAR(); } } while (0)
    {
        pg8::Gemm g{bufB, wo0t, M, DM, DM}; pg8::StaticOrder S; S.init(M, DM, G, vid);
        { pg8::Unit uu; int last = -1;
          for (int i = 0; S.next(i, uu); ++i) if (uu.pm != last) { conv_fix_panel((const float*)(ws + WS_HA), (const float*)(ws + WS_HB), w_conv, bufB, uu.pm, tid); last = uu.pm; }
          asm volatile("s_waitcnt vmcnt(0)" ::: "memory"); __syncthreads(); }
        pg8::EpiResid<2> E{bufA, x1b, sumsq1, rstd0, norm0_w};
        pg8::gemm_phase<pg8::EpiResid<2>, pg8::StaticOrder, true, true>(lds, g, S, E);
    }
    QUAD_OR_GRID_BAR();
    for (int rep = 0; rep < REP_P4; ++rep) {
        pg8::Gemm g{x1b, w1t, M, N1, DM}; pg8::StaticOrder S; S.init(M, N1, G, vid);
        pg8::EpiQKVG E{bufA, (long)((WS_BUFD - WS_BUFA) / 2), vf, sumsq1, lds + 133120};
        pg8::gemm_phase<pg8::EpiQKVG, pg8::StaticOrder, true, true>(lds, g, S, E);
        { pg8::Unit u0; (void)S.next(0, u0); gklr_phase(lds, x1b, wgt, sumsq1, gklr, G, quadmode ? 16 * u0.pm + 4 * (vid >> 6) : (int)blockIdx.x * 4, wave, lane); }
    }
    QUAD_OR_GRID_BAR();
    for (int rep = 0; rep < REP_P5; ++rep) gate_phase(lds, bufA, bufC, gklr, w_gk2, b_gk2, qf, kf, pf, vf, eb, G, vid, qpm, tid, wave, lane);
    GRID_BAR();
    scan_phase(lds, qf, kf, pf, vf, eb, bufA, bufB, G, vid, tid, wave, lane);
    GRID_BAR();
    outgate_phase(bufA, bufB, bufD, gn_w, gw, NGW, lane);
    GRID_BAR();
    {
        pg8::Gemm g{bufA, wo1t, M, DM, DM}; pg8::StaticOrder S; S.init(M, DM, G, vid);
        pg8::EpiResid<1> E{x1b, bufB, sumsq2, nullptr, nullptr};
        pg8::gemm_phase<pg8::EpiResid<1>, pg8::StaticOrder, true, true>(lds, g, S, E);
    }
    GRID_BAR();
    final_norm_phase(bufB, a.out, sumsq2, normf_w, gt, NT);
}

extern "C" void kernel_launch(void* const* d_in, const int* in_sizes, int n_in, void* d_out, int out_size, void* d_ws, size_t ws_size, hipStream_t stream) {
    static int grid = 0;
    if (grid == 0) {
        if (n_in != 12 || in_sizes[0] != M * DM || out_size != M * DM || ws_size < WS_END) { fprintf(stderr, "kernel_launch: unexpected shapes (n_in %d, in0 %d, out %d, ws %zu); nothing launched\n", n_in, n_in > 0 ? in_sizes[0] : -1, out_size, ws_size); grid = -1; return; }
        int dev = 0, cus = 0, per_cu = 0;
        if (hipGetDevice(&dev) != hipSuccess || hipDeviceGetAttribute(&cus, hipDeviceAttributeMultiprocessorCount, dev) != hipSuccess) { fprintf(stderr, "kernel_launch: device query failed\n"); grid = -1; return; }
        if (hipFuncSetAttribute((const void*)hybrid_fwd, hipFuncAttributeMaxDynamicSharedMemorySize, LDS_BYTES) != hipSuccess) { fprintf(stderr, "kernel_launch: hipFuncSetAttribute failed\n"); grid = -1; return; }
        if (hipOccupancyMaxActiveBlocksPerMultiprocessor(&per_cu, (const void*)hybrid_fwd, NWAVES * 64, LDS_BYTES) != hipSuccess || per_cu < 1) { fprintf(stderr, "kernel_launch: occupancy query says %d blocks per CU\n", per_cu); per_cu = 1; }
        (void)hipGetLastError();
        grid = cus * per_cu;
    }
    if (grid < 0) return;
    (void)hipMemsetAsync((char*)d_ws + WS_CTL, 0, CTL_ZERO_BYTES, stream);
    Args a{};
    for (int i = 0; i < 12; ++i) a.in[i] = (const float*)d_in[i];
    a.out = (float*)d_out; a.ws = (unsigned char*)d_ws;
    void* params[] = {&a};
    hipError_t e = hipLaunchCooperativeKernel((const void*)hybrid_fwd, dim3(grid), dim3(NWAVES * 64), params, LDS_BYTES, stream);
    if (e != hipSuccess) fprintf(stderr, "kernel_launch: cooperative launch failed: %s (grid %d)\n", hipGetErrorString(e), grid);
}
```

```cpp
#include <hip/hip_runtime.h>
#include <hip/hip_cooperative_groups.h>
#include <cstdio>
#include <cstdint>
namespace cg = cooperative_groups;
namespace pg8 {
#define PG8_LAS __attribute__((address_space(3)))
typedef unsigned short bf16_t;
typedef short bf16x8 __attribute__((ext_vector_type(8)));
typedef float f32x4 __attribute__((ext_vector_type(4)));
typedef unsigned u32x4 __attribute__((ext_vector_type(4)));
constexpr int BM = 256, BK = 64, HALF = 128, HTB = HALF * BK * 2  , STAGE_BYTES = 8 * HTB, NXCD = 8, WGM = 8;

__host__ __device__ __forceinline__ int lds_byte(int r, int c) { const int st = (r >> 4) * 2 + (c >> 5), rr = r & 15, cc = c & 31, ob = rr * 64 + cc * 2; return st * 1024 + (ob ^ (((ob >> 9) & 1) << 5)); }
__host__ __device__ __forceinline__ void stage_rc(int b, int& R, int& C) { const int st = b / 1024, sb = b % 1024, swz = sb ^ (((sb >> 9) & 1) << 5); R = (st >> 1) * 16 + swz / 64; C = (st & 1) * 32 + (swz % 64) / 2; }
__host__ __device__ __forceinline__ int perm32(int rho) { const int n = rho >> 4, i = rho & 15; return 8 * (i >> 2) + 4 * n + (i & 3); }

struct Unit { int pm, pn; };
struct Gemm { const bf16_t* A; const bf16_t* Bt; int M, N, K; };

struct StaticOrder {
    int nM, nN, nwg, G, c;
    __host__ __device__ void init(int M, int N, int G_, int c_) { nM = M / BM; nN = N / BM; nwg = nM * nN; G = G_; c = c_; }
    __host__ __device__ bool next(int i, Unit& u) const {
        const long L = (long)i * G + c; if (L >= nwg) return false;
        int wgid = (int)L; { const int q = nwg / NXCD, r = nwg % NXCD, xcd = wgid % NXCD, off = wgid / NXCD; wgid = (xcd < r ? xcd * (q + 1) : r * (q + 1) + (xcd - r) * q) + off; }
        const int nig = WGM * nN, gid = wgid / nig, fm = gid * WGM, gsz = (nM - fm) < WGM ? (nM - fm) : WGM;
        u.pm = fm + ((wgid % nig) % gsz); u.pn = (wgid % nig) / gsz; return true;
    }
    __device__ __forceinline__ void a_ready(const Unit&) const {}
    __device__ __forceinline__ void done(const Unit&) const {}
};

__device__ __forceinline__ unsigned cvt_pk_bf16(float lo, float hi) { unsigned r; asm volatile("v_cvt_pk_bf16_f32 %0, %1, %2" : "=v"(r) : "v"(lo), "v"(hi)); return r; }
typedef float f32x2 __attribute__((ext_vector_type(2)));
typedef unsigned u32x2 __attribute__((ext_vector_type(2)));
constexpr float RMS_EPS = 1e-6f;
struct EpiConvFused {
    static constexpr bool PERM = false, AFTER_DRAIN = false;
    bf16_t* Y; const float* wconv; float* HA; float* HB; PG8_LAS float* xch;
    __device__ __forceinline__ void operator()(const f32x4 (&acc)[2][2][4][2], const Unit& u, int wr, int wc, int fr, int fq) const {
        const int row0 = u.pm * BM + wr * 64 + fr; const int ch = wc * 16 + 4 * fq, e0 = u.pn * 64 + ch;
        f32x4 w0, w1, w2;
#pragma unroll
        for (int j = 0; j < 4; ++j) { w0[j] = wconv[(e0 + j) * 3 + 0]; w1[j] = wconv[(e0 + j) * 3 + 1]; w2[j] = wconv[(e0 + j) * 3 + 2]; }
#pragma unroll
        for (int ai = 0; ai < 2; ++ai) { const f32x4 cu3 = acc[ai][0][3][1] * acc[ai][1][3][0];
            if (fr >= 14) *(PG8_LAS f32x4*)(xch + ((2 * ai + wr) * 2 + (fr - 14)) * 64 + ch) = cu3; }
        asm volatile("s_waitcnt lgkmcnt(0)" ::: "memory"); __builtin_amdgcn_s_barrier(); asm volatile("" ::: "memory");
#pragma unroll
        for (int ai = 0; ai < 2; ++ai) {
            const int blk = 2 * ai + wr;
            f32x4 l14 = {0.f, 0.f, 0.f, 0.f}, l15 = {0.f, 0.f, 0.f, 0.f};
            if (blk > 0) { const f32x4 rm2 = *(const PG8_LAS f32x4*)(xch + ((blk - 1) * 2 + 0) * 64 + ch), rm1 = *(const PG8_LAS f32x4*)(xch + ((blk - 1) * 2 + 1) * 64 + ch);
                l15 = rm1; l14 = (fr == 0) ? rm2 : rm1; }
#pragma unroll
            for (int m = 0; m < 4; ++m) {
                const int row = row0 + ai * HALF + m * 16;
                const f32x4 b = acc[ai][0][m][0], c = acc[ai][0][m][1], uu = acc[ai][1][m][0], z = acc[ai][1][m][1];
                const f32x4 cu = c * uu; f32x4 bz, p1, p2;
#pragma unroll
                for (int j = 0; j < 4; ++j) {
                    bz[j] = b[j] * z[j] * __builtin_amdgcn_rcpf(1.f + __expf(-z[j]));
                    const float r1 = __int_as_float(__builtin_amdgcn_update_dpp(0, __float_as_int(cu[j]), 0x121, 0xf, 0xf, false));
                    const float r2 = __int_as_float(__builtin_amdgcn_update_dpp(0, __float_as_int(cu[j]), 0x122, 0xf, 0xf, false));
                    p1[j] = fr >= 1 ? r1 : l15[j];
                    p2[j] = fr >= 2 ? r2 : l14[j];
                    l15[j] = r1; l14[j] = r2;
                }
                const f32x4 y = bz * (w0 * p2 + w1 * p1 + w2 * cu);
                u32x2 wv; wv.x = cvt_pk_bf16(y[0], y[1]); wv.y = cvt_pk_bf16(y[2], y[3]);
                *(u32x2*)(Y + (size_t)row * 2048 + e0) = wv;
                if (blk == 0 && m == 0 && fr < 2) { *(f32x4*)(HA + ((size_t)u.pm * 4 + fr) * 2048 + e0) = bz; *(f32x4*)(HA + ((size_t)u.pm * 4 + 2 + fr) * 2048 + e0) = cu; }
                if (blk == 3 && m == 3 && fr >= 14) *(f32x4*)(HB + ((size_t)u.pm * 2 + (fr - 14)) * 2048 + e0) = cu;
            }
        }
        asm volatile("s_waitcnt lgkmcnt(0)" ::: "memory"); __builtin_amdgcn_s_barrier(); asm volatile("" ::: "memory");
    }
};
template <int BASE_MODE> struct EpiResid {
    static constexpr bool PERM = true, AFTER_DRAIN = false; static constexpr bool BASE_BF16 = BASE_MODE != 0;
    const void* base; bf16_t* outb; float* sumsq; const float* rs0; const float* nw0;
    __device__ __forceinline__ void operator()(const f32x4 (&acc)[2][2][4][2], const Unit& u, int wr, int wc, int fr, int fq) const {
        const int row0 = u.pm * BM + wr * 64 + fr; const int col0 = u.pn * BM + wc * 32 + 8 * fq;
        f32x4 iw[2][2];
        if (BASE_MODE == 2) {
#pragma unroll
            for (int bj = 0; bj < 2; ++bj)
#pragma unroll
                for (int n = 0; n < 2; ++n) { const f32x4 w = *(const f32x4*)(nw0 + col0 + bj * HALF + 4 * n);
#pragma unroll
                    for (int j = 0; j < 4; ++j) iw[bj][n][j] = __builtin_amdgcn_rcpf(w[j]); }
        }
#pragma unroll
        for (int ai = 0; ai < 2; ++ai) {
            f32x4 bv[4][2][2];
#pragma unroll
            for (int m = 0; m < 4; ++m)
#pragma unroll
                for (int bj = 0; bj < 2; ++bj) { const size_t o = (size_t)(row0 + ai * HALF + m * 16) * 2048 + col0 + bj * HALF;
                    if (BASE_BF16) { const u32x4 w = __builtin_nontemporal_load((const u32x4*)((const bf16_t*)base + o));
                        bv[m][bj][0] = (f32x4){__uint_as_float(w.x << 16), __uint_as_float(w.x & 0xffff0000u), __uint_as_float(w.y << 16), __uint_as_float(w.y & 0xffff0000u)};
                        bv[m][bj][1] = (f32x4){__uint_as_float(w.z << 16), __uint_as_float(w.z & 0xffff0000u), __uint_as_float(w.w << 16), __uint_as_float(w.w & 0xffff0000u)};
                        if (BASE_MODE == 2) { const float irs = __builtin_amdgcn_rcpf(rs0[row0 + ai * HALF + m * 16]); bv[m][bj][0] = bv[m][bj][0] * iw[bj][0] * irs; bv[m][bj][1] = bv[m][bj][1] * iw[bj][1] * irs; } }
                    else { bv[m][bj][0] = *(const f32x4*)((const float*)base + o); bv[m][bj][1] = *(const f32x4*)((const float*)base + o + 4); } }
#pragma unroll
            for (int m = 0; m < 4; ++m) {
                const int row = row0 + ai * HALF + m * 16; float s = 0.f;
#pragma unroll
                for (int bj = 0; bj < 2; ++bj) {
                    const f32x4 v0 = bv[m][bj][0] + acc[ai][bj][m][0], v1 = bv[m][bj][1] + acc[ai][bj][m][1];
                    s += ((v0[0] * v0[0] + v0[1] * v0[1]) + (v0[2] * v0[2] + v0[3] * v0[3])) + ((v1[0] * v1[0] + v1[1] * v1[1]) + (v1[2] * v1[2] + v1[3] * v1[3]));
                    u32x4 w; w.x = cvt_pk_bf16(v0[0], v0[1]); w.y = cvt_pk_bf16(v0[2], v0[3]); w.z = cvt_pk_bf16(v1[0], v1[1]); w.w = cvt_pk_bf16(v1[2], v1[3]);
                    *(u32x4*)(outb + (size_t)row * 2048 + col0 + bj * HALF) = w;
                }
                s += __shfl_xor(s, 16); s += __shfl_xor(s, 32);
                if (fq == 0) unsafeAtomicAdd(sumsq + row, s);
            }
            asm volatile("" ::: "memory");
        }
    }
};
struct EpiQKVG {
    static constexpr bool PERM = true, AFTER_DRAIN = false;
    bf16_t* QK; long dG; bf16_t* VFp; const float* sumsq1; PG8_LAS unsigned char* scr;
    __device__ __forceinline__ void operator()(const f32x4 (&acc)[2][2][4][2], const Unit& u, int wr, int wc, int fr, int fq) const {
        const int row0 = u.pm * BM + wr * 64 + fr; const int sel = u.pn < 8 ? 1 : (u.pn < 16 ? 2 : 0);
        const int col0 = (u.pn & 7) * BM + wc * 32 + 8 * fq; const float sc0 = (u.pn >= 16 && u.pn < 20) ? 0.0625f : 1.0f;
        if (sel != 1) {
            bf16_t* basep = QK + (sel >= 2 ? dG : 0L);
#pragma unroll
            for (int ai = 0; ai < 2; ++ai)
#pragma unroll
                for (int m = 0; m < 4; ++m) {
                    const int row = row0 + ai * HALF + m * 16; const float rs = rsqrtf(sumsq1[row] * (1.0f / 2048.0f) + RMS_EPS) * sc0;
                    bf16_t* rowp = basep + (size_t)row * 2048 + col0;
#pragma unroll
                    for (int bj = 0; bj < 2; ++bj) { const f32x4 v0 = acc[ai][bj][m][0] * rs, v1 = acc[ai][bj][m][1] * rs;
                        u32x4 w; w.x = cvt_pk_bf16(v0[0], v0[1]); w.y = cvt_pk_bf16(v0[2], v0[3]); w.z = cvt_pk_bf16(v1[0], v1[1]); w.w = cvt_pk_bf16(v1[2], v1[3]);
                        *(u32x4*)(rowp + bj * HALF) = w; }
                }
        } else {
            const int wid = wr * 4 + wc; PG8_LAS unsigned char* my = scr + wid * 1280;
            const int lane = fq * 16 + fr, et = lane >> 5, hh = (lane >> 4) & 1, c = lane & 15, cc = 8 * (c >> 2) + 4 * et + (c & 3);
            const int b = u.pm >> 5, h = (u.pn & 7) >> 1;
#pragma unroll
            for (int ai = 0; ai < 2; ++ai) {
                const int chunk = (4 * u.pm + 2 * ai + wr) & 127; const size_t it = (size_t)(4 * b + h) * 128 + chunk;
#pragma unroll
                for (int m = 0; m < 4; ++m) {
                    const int row = row0 + ai * HALF + m * 16; const float rs = rsqrtf(sumsq1[row] * (1.0f / 2048.0f) + RMS_EPS);
#pragma unroll
                    for (int bj = 0; bj < 2; ++bj) { const f32x4 v0 = acc[ai][bj][m][0] * rs, v1 = acc[ai][bj][m][1] * rs;
                        u32x4 w; w.x = cvt_pk_bf16(v0[0], v0[1]); w.y = cvt_pk_bf16(v0[2], v0[3]); w.z = cvt_pk_bf16(v1[0], v1[1]); w.w = cvt_pk_bf16(v1[2], v1[3]);
                        *(PG8_LAS u32x4*)(my + fr * 80 + fq * 16) = w;
                        asm volatile("s_waitcnt lgkmcnt(0)" ::: "memory");
                        unsigned short hv[8];
#pragma unroll
                        for (int jj = 0; jj < 8; ++jj) hv[jj] = *(const PG8_LAS unsigned short*)(my + (8 * hh + jj) * 80 + cc * 2);
                        u32x4 o; o.x = (unsigned)hv[0] | ((unsigned)hv[1] << 16); o.y = (unsigned)hv[2] | ((unsigned)hv[3] << 16); o.z = (unsigned)hv[4] | ((unsigned)hv[5] << 16); o.w = (unsigned)hv[6] | ((unsigned)hv[7] << 16);
                        const int ne2 = 8 * (u.pn & 1) + 4 * bj + wc, ne = 2 * ne2 + et, sblk = m >> 1, q = 2 * (m & 1) + hh;
                        __builtin_nontemporal_store(o, (u32x4*)(VFp + ((it * 64 + ne * 2 + sblk) * 64 + 16 * q + c) * 8));
                        asm volatile("s_waitcnt lgkmcnt(0)" ::: "memory");
                    }
                }
            }
        }
    }
};
template <class Epi, class Sched, bool ALIGN_EPI = false, bool SP2 = false>
__device__ __forceinline__ void gemm_phase(PG8_LAS unsigned char* lds, const Gemm g, const Sched& S, const Epi& E) {
    const int tid = threadIdx.x, wid = __builtin_amdgcn_readfirstlane(tid >> 6), lane = tid & 63, wr = wid >> 2, wc = wid & 3, fr = lane & 15, fq = lane >> 4;
    const int K = g.K, nt = K / BK;
    unsigned voffA[2], voffB[2];
#pragma unroll
    for (int i = 0; i < 2; ++i) { int R, C; stage_rc(tid * 16 + i * 8192, R, C); const int Rb = Epi::PERM ? ((R & ~31) + perm32(R & 31)) : R;
        voffA[i] = (unsigned)(R * K + C) * 2u; voffB[i] = (unsigned)(Rb * K + C) * 2u; }
    const size_t kstep = (size_t)(BK * 2);
    const size_t hstep = (size_t)HALF * K * 2;
    const size_t tstep = 2 * hstep;
    const unsigned ldsw = (unsigned)wid * 1024u;
    const int aoff = lds_byte(wr * 64 + fr, fq * 8), boff = lds_byte(wc * 32 + fr, fq * 8);
#define PG8_SA(b, h) (((b) * 2 + (h)) * HTB)
#define PG8_SB(b, h) ((4 + (b) * 2 + (h)) * HTB)
#define PG8_STAGE(bufoff, gbase, voff) do { _Pragma("unroll") for (int _i = 0; _i < 2; ++_i) \
        __builtin_amdgcn_global_load_lds((const unsigned*)((const char*)(gbase) + (voff)[_i]), (PG8_LAS unsigned*)(lds + (bufoff) + ldsw + _i * 8192), 16, 0, 0); } while (0)
#define PG8_LDA(dst, b, h) do { _Pragma("unroll") for (int m = 0; m < 4; ++m) _Pragma("unroll") for (int k = 0; k < 2; ++k) dst[m][k] = *(const PG8_LAS bf16x8*)(lds + PG8_SA(b, h) + aoff + m * 2048 + k * 1024); } while (0)
#define PG8_LDB(dst, b, h) do { _Pragma("unroll") for (int n = 0; n < 2; ++n) _Pragma("unroll") for (int k = 0; k < 2; ++k) dst[n][k] = *(const PG8_LAS bf16x8*)(lds + PG8_SB(b, h) + boff + n * 2048 + k * 1024); } while (0)
#define PG8_MMA(ai, bj, At, Bt) do { __builtin_amdgcn_s_setprio(1); _Pragma("unroll") for (int m = 0; m < 4; ++m) _Pragma("unroll") for (int n = 0; n < 2; ++n) _Pragma("unroll") for (int k = 0; k < 2; ++k) \
        acc[ai][bj][m][n] = __builtin_amdgcn_mfma_f32_16x16x32_bf16(Bt[n][k], At[m][k], acc[ai][bj][m][n], 0, 0, 0); __builtin_amdgcn_s_setprio(0); } while (0)
#define PG8_WAIT_V(n) asm volatile("s_waitcnt vmcnt(" #n ")" ::: "memory")
#define PG8_WAIT_L(n) asm volatile("s_waitcnt lgkmcnt(" #n ")" ::: "memory")
#define PG8_BAR __builtin_amdgcn_s_barrier()
#define PG8_SCHED __builtin_amdgcn_sched_barrier(0)
    Unit cur, nxt; int ui = 0;
    if (!S.next(0, cur)) return;
    f32x4 acc[2][2][4][2];
#pragma unroll
    for (int a = 0; a < 2; ++a)
#pragma unroll
        for (int b = 0; b < 2; ++b)
#pragma unroll
            for (int m = 0; m < 4; ++m)
#pragma unroll
                for (int n = 0; n < 2; ++n) acc[a][b][m][n] = (f32x4){0.f, 0.f, 0.f, 0.f};
    bf16x8 At[4][2], B0[2][2], B1[2][2];
    const char* cA = (const char*)g.A + (size_t)cur.pm * tstep; const char* cB = (const char*)g.Bt + (size_t)cur.pn * tstep;
    S.a_ready(cur);
    if constexpr (SP2) {
        PG8_STAGE(PG8_SB(0, 0), cB, voffB); PG8_STAGE(PG8_SB(0, 1), cB + hstep, voffB); PG8_STAGE(PG8_SA(0, 0), cA, voffA); PG8_STAGE(PG8_SA(0, 1), cA + hstep, voffA);
        if (wr == 1) PG8_BAR;
        PG8_WAIT_V(2); PG8_BAR;
        PG8_STAGE(PG8_SB(1, 0), cB + kstep, voffB); PG8_STAGE(PG8_SA(1, 0), cA + kstep, voffA); PG8_STAGE(PG8_SB(1, 1), cB + hstep + kstep, voffB);
        PG8_WAIT_V(6); PG8_BAR;
    } else {
        PG8_STAGE(PG8_SB(0, 0), cB, voffB); PG8_STAGE(PG8_SA(0, 0), cA, voffA); PG8_STAGE(PG8_SB(0, 1), cB + hstep, voffB); PG8_STAGE(PG8_SA(0, 1), cA + hstep, voffA);
        if (wr == 1) PG8_BAR;
        PG8_WAIT_V(4); PG8_BAR;
        PG8_STAGE(PG8_SB(1, 0), cB + kstep, voffB); PG8_STAGE(PG8_SA(1, 0), cA + kstep, voffA); PG8_STAGE(PG8_SB(1, 1), cB + hstep + kstep, voffB);
        PG8_WAIT_V(6); PG8_BAR;
    }
    for (;;) {
        const bool has_next = S.next(ui + 1, nxt);
        const char* nA = has_next ? (const char*)g.A + (size_t)nxt.pm * tstep : cA; const char* nB = has_next ? (const char*)g.Bt + (size_t)nxt.pn * tstep : cB;
        for (int t = 0; t < nt; t += 2) {
            const bool last = (t == nt - 2);
            const char* a1 = cA + (size_t)(t + 1) * kstep;
            const char* a2 = last ? nA : cA + (size_t)(t + 2) * kstep; const char* b2 = last ? nB : cB + (size_t)(t + 2) * kstep;
            const char* a3 = a2 + kstep; const char* b3 = b2 + kstep;
            if (last && has_next) S.a_ready(nxt);
            if constexpr (SP2) {
            PG8_LDB(B0, 0, 0); PG8_LDB(B1, 0, 1); PG8_SCHED; PG8_LDA(At, 0, 0); PG8_STAGE(PG8_SA(1, 1), a1 + hstep, voffA);
            PG8_WAIT_V(8); PG8_WAIT_L(0); PG8_BAR; PG8_MMA(0, 0, At, B0); PG8_MMA(0, 1, At, B1); PG8_BAR; PG8_SCHED;
            PG8_LDA(At, 0, 1); PG8_STAGE(PG8_SB(0, 0), b2, voffB); PG8_STAGE(PG8_SB(0, 1), b2 + hstep, voffB); PG8_STAGE(PG8_SA(0, 0), a2, voffA);
            PG8_WAIT_V(8); PG8_WAIT_L(0); PG8_BAR; PG8_MMA(1, 0, At, B0); PG8_MMA(1, 1, At, B1); PG8_BAR; PG8_SCHED;
            PG8_LDB(B0, 1, 0); PG8_LDB(B1, 1, 1); PG8_SCHED; PG8_LDA(At, 1, 0); PG8_STAGE(PG8_SA(0, 1), a2 + hstep, voffA);
            PG8_WAIT_V(8); PG8_WAIT_L(0); PG8_BAR; PG8_MMA(0, 0, At, B0); PG8_MMA(0, 1, At, B1); PG8_BAR; PG8_SCHED;
            PG8_LDA(At, 1, 1); PG8_STAGE(PG8_SB(1, 0), b3, voffB); PG8_STAGE(PG8_SB(1, 1), b3 + hstep, voffB); PG8_STAGE(PG8_SA(1, 0), a3, voffA);
            PG8_WAIT_V(8); PG8_WAIT_L(0); PG8_BAR; PG8_MMA(1, 0, At, B0); PG8_MMA(1, 1, At, B1); PG8_BAR; PG8_SCHED;
            } else {
            PG8_LDB(B0, 0, 0); PG8_SCHED; PG8_LDA(At, 0, 0); PG8_STAGE(PG8_SA(1, 1), a1 + hstep, voffA);
            PG8_WAIT_L(8); PG8_BAR; PG8_WAIT_L(0); PG8_MMA(0, 0, At, B0); PG8_BAR; PG8_SCHED;
            PG8_LDB(B1, 0, 1); PG8_STAGE(PG8_SB(0, 0), b2, voffB);
            PG8_BAR; PG8_WAIT_L(0); PG8_MMA(0, 1, At, B1); PG8_BAR;
            PG8_LDA(At, 0, 1); PG8_STAGE(PG8_SA(0, 0), a2, voffA);
            PG8_BAR; PG8_WAIT_L(0); PG8_MMA(1, 0, At, B0); PG8_BAR; PG8_SCHED;
            PG8_STAGE(PG8_SB(0, 1), b2 + hstep, voffB);
            PG8_WAIT_V(6); PG8_BAR; PG8_MMA(1, 1, At, B1); PG8_BAR;
            PG8_LDB(B0, 1, 0); PG8_SCHED; PG8_LDA(At, 1, 0); PG8_STAGE(PG8_SA(0, 1), a2 + hstep, voffA);
            PG8_WAIT_L(8); PG8_BAR; PG8_WAIT_L(0); PG8_MMA(0, 0, At, B0); PG8_BAR; PG8_SCHED;
            PG8_LDB(B1, 1, 1); PG8_STAGE(PG8_SB(1, 0), b3, voffB);
            PG8_BAR; PG8_WAIT_L(0); PG8_MMA(0, 1, At, B1); PG8_BAR;
            PG8_LDA(At, 1, 1); PG8_STAGE(PG8_SA(1, 0), a3, voffA);
            PG8_BAR; PG8_WAIT_L(0); PG8_MMA(1, 0, At, B0); PG8_BAR; PG8_SCHED;
            PG8_STAGE(PG8_SB(1, 1), b3 + hstep, voffB);
            PG8_WAIT_V(6); PG8_BAR; PG8_MMA(1, 1, At, B1); PG8_BAR;
            }
        }
        if constexpr (ALIGN_EPI) { if (wr == 0) PG8_BAR; }
        if constexpr (!Epi::AFTER_DRAIN) { E(acc, cur, wr, wc, fr, fq); S.done(cur); }
        if (!has_next) break;
#pragma unroll
        for (int a = 0; a < 2; ++a)
#pragma unroll
            for (int b = 0; b < 2; ++b)
#pragma unroll
                for (int m = 0; m < 4; ++m)
#pragma unroll
                    for (int n = 0; n < 2; ++n) acc[a][b][m][n] = (f32x4){0.f, 0.f, 0.f, 0.f};
        cur = nxt; cA = nA; cB = nB; ++ui;
        if constexpr (ALIGN_EPI) { if (wr == 1) PG8_BAR; }
    }
    PG8_WAIT_V(0);
    if constexpr (!ALIGN_EPI) { if (wr == 0) PG8_BAR; }
    PG8_BAR;
    if constexpr (Epi::AFTER_DRAIN) { E.fused(acc, cur, wr, wc, fr, fq, lds, wid, lane); S.done(cur); }
#undef PG8_SA
#undef PG8_SB
#undef PG8_STAGE
#undef PG8_LDA
#undef PG8_LDB
#undef PG8_MMA
#undef PG8_WAIT_V
#undef PG8_WAIT_L
#undef PG8_BAR
#undef PG8_SCHED
}
}
constexpr int M = 16384, DM = 2048, TSEQ = 8192, N0 = 8192, N1 = 6144, N1RAW = 6160, NHEAD = 4, DK = 256, DV = 512, CH = 64, NCH = 128;
constexpr float EPS = 1e-6f;
constexpr int NWAVES = 8;
constexpr size_t MiB = 1u << 20;
constexpr size_t WS_CTL = 0, CTL_ZERO_BYTES = 2 * MiB;
constexpr size_t WS_SUMSQ1 = 1 * MiB, WS_SUMSQ2 = 1 * MiB + 65536, WS_HSUM = 1 * MiB + 131072;
constexpr size_t WS_GKLR = 2 * MiB;
constexpr size_t WS_EB = 3 * MiB;
constexpr size_t WS_WGT = 4 * MiB;
constexpr size_t WS_RSTD0 = 4 * MiB + 524288;
constexpr size_t WS_HA = 5 * MiB, WS_HB = 7 * MiB;
constexpr size_t WS_W0T = 8 * MiB, WS_WO0T = 40 * MiB, WS_W1T = 48 * MiB, WS_WO1T = 72 * MiB;
constexpr size_t WS_VF = 336 * MiB;
constexpr size_t WS_BUFA = 80 * MiB;
constexpr size_t WS_BUFB = 144 * MiB;
constexpr size_t WS_BUFC = 208 * MiB;
constexpr size_t WS_X1 = 272 * MiB;
constexpr size_t WS_BUFD = 400 * MiB;
constexpr size_t WS_PF = 464 * MiB;
constexpr size_t WS_DUMMY = 472 * MiB;
constexpr size_t WS_END = 473 * MiB;
constexpr int LDS_BYTES = 147456;

#define GAS __attribute__((address_space(1)))
#define LAS __attribute__((address_space(3)))
typedef unsigned short bf16;
typedef unsigned v4u __attribute__((ext_vector_type(4)));
typedef unsigned v2u __attribute__((ext_vector_type(2)));
typedef float f32x4 __attribute__((ext_vector_type(4)));
typedef float f32x2 __attribute__((ext_vector_type(2)));
typedef short bf16x8 __attribute__((ext_vector_type(8)));
#define LDS_WAIT() asm volatile("s_waitcnt lgkmcnt(0)" ::: "memory")
#define WG_BAR() do { asm volatile("s_waitcnt lgkmcnt(0)" ::: "memory"); __builtin_amdgcn_s_barrier(); asm volatile("" ::: "memory"); } while (0)
#define MFMA16(a, b, c) __builtin_amdgcn_mfma_f32_16x16x32_bf16((a), (b), (c), 0, 0, 0)
__device__ __forceinline__ unsigned pk2(float lo, float hi) { return pg8::cvt_pk_bf16(lo, hi); }
__device__ __forceinline__ unsigned f2bf_sw(float f) { const unsigned u = __float_as_uint(f); return (u + 0x7fffu + ((u >> 16) & 1u)) >> 16; }
__device__ __forceinline__ unsigned pk2_sw(float lo, float hi) { return f2bf_sw(lo) | (f2bf_sw(hi) << 16); }
__device__ __forceinline__ float bflo(unsigned u) { return __uint_as_float(u << 16); }
__device__ __forceinline__ float bfhi(unsigned u) { return __uint_as_float(u & 0xffff0000u); }
__device__ __forceinline__ float wave_sum(float v) {
#pragma unroll
    for (int o = 1; o < 64; o <<= 1) v += __shfl_xor(v, o);
    return v;
}
#define XB_TMO      128
#define XB_XCNT(j)  (256  + 64 * (j))
#define XB_XSUB(j)  (1280 + 64 * (j))
#define XB_XGEN(j)  (2304 + 64 * (j))
#define XB_TOP      3328
#define XB_TOPGEN   3392
#define XCD_BAR_WORDS 3456
#define XB_SPIN_CAP (1u << 18)

__device__ __forceinline__ unsigned xb_ld(unsigned* p)              { return __hip_atomic_load(p, __ATOMIC_RELAXED, __HIP_MEMORY_SCOPE_AGENT); }
__device__ __forceinline__ unsigned xb_add(unsigned* p, unsigned v) { return __hip_atomic_fetch_add(p, v, __ATOMIC_RELAXED, __HIP_MEMORY_SCOPE_AGENT); }
__device__ __forceinline__ unsigned xb_xcc_id() { return (unsigned)__builtin_amdgcn_s_getreg((3 << 11) | 20) & 0xFu; }
#define XB_SPIN(cond, bar) do { unsigned _sp = 0; while (cond) { __builtin_amdgcn_s_sleep(1); \
    if ((++_sp & 255u) == 0u) { if (xb_ld(&(bar)[XB_TMO])) break; if (_sp > XB_SPIN_CAP) { atomicAdd(&(bar)[XB_TMO], 1u); break; } } } } while (0)

struct XcdBarrier {
    unsigned* bar; unsigned x;
    volatile LAS unsigned* st;
};

__device__ __forceinline__ XcdBarrier xcd_barrier_post(unsigned* bar, volatile LAS unsigned* st) {
    XcdBarrier b; b.bar = bar; b.x = xb_xcc_id(); b.st = st;
    if (threadIdx.x == 0) (void)xb_add(&bar[XB_XCNT(b.x)], 1u);
    return b;
}
__device__ __forceinline__ void xcd_barrier_complete(unsigned* bar, unsigned x, unsigned& nloc, unsigned& nx) {
    const unsigned G = gridDim.x * gridDim.y * gridDim.z;
    unsigned sum, cnt, mine, sp = 0u;
    for (;;) {
        sum = 0u; cnt = 0u; mine = 0u;
#pragma unroll
        for (unsigned j = 0; j < 16; ++j) { const unsigned c = xb_ld(&bar[XB_XCNT(j)]); sum += c; cnt += (c > 0u) ? 1u : 0u; mine = (j == x) ? c : mine; }
        if (sum == G) break;
        __builtin_amdgcn_s_sleep(1);
        if ((++sp & 255u) == 0u) { if (xb_ld(&bar[XB_TMO])) break; if (sp > XB_SPIN_CAP) { atomicAdd(&bar[XB_TMO], 1u); break; } }
    }
    nloc = mine > 0u ? mine : 1u; nx = cnt > 0u ? cnt : 1u;
}

__device__ __forceinline__ void xcd_barrier(const XcdBarrier& b) {
    asm volatile("s_waitcnt vmcnt(0)" ::: "memory");
    __syncthreads();
    if (threadIdx.x == 0) {
        unsigned* bar = b.bar;
        __builtin_amdgcn_s_waitcnt(0);
        unsigned nloc = b.st[0], nx = b.st[1];
        if (nloc == 0u) { xcd_barrier_complete(bar, b.x, nloc, nx); b.st[0] = nloc; b.st[1] = nx; }
        const unsigned old = xb_add(&bar[XB_XSUB(b.x)], 1u);
        const unsigned gen = old / nloc;
        if (old + 1u == (gen + 1u) * nloc) {
            __builtin_amdgcn_fence(__ATOMIC_RELEASE, "agent");
            asm volatile("s_waitcnt vmcnt(0)" ::: "memory");
            const unsigned og = xb_add(&bar[XB_TOP], 1u);
            const unsigned tg = og / nx;
            if (og + 1u == (tg + 1u) * nx) xb_add(&bar[XB_TOPGEN], 1u);
            else XB_SPIN(xb_ld(&bar[XB_TOPGEN]) == tg, bar);
            __builtin_amdgcn_fence(__ATOMIC_ACQUIRE, "agent");
            xb_add(&bar[XB_XGEN(b.x)], 1u);
            asm volatile("s_waitcnt vmcnt(0)" ::: "memory");
        } else {
            XB_SPIN(xb_ld(&bar[XB_XGEN(b.x)]) == gen, bar);
            __builtin_amdgcn_fence(__ATOMIC_ACQUIRE, "agent");
            asm volatile("s_waitcnt vmcnt(0)" ::: "memory");
        }
    }
    __syncthreads();
}
__device__ __forceinline__ int virt0(int col) { const int g = col >> 11, e = col & 2047, pn = e >> 6, el = e & 63; return 256 * pn + 128 * (g >> 1) + 32 * (el >> 4) + 16 * (g & 1) + (el & 15); }
__device__ __forceinline__ void p0_transpose_item(const float* W, int ldw, int nblk, int K, bf16* WT, int mode, const float* rowscale, LAS float* scr, int item, int lane) {
    const int kb = item / nblk, nb = item % nblk, k0 = 64 * kb, n0 = 32 * nb;
    f32x4 wv[8]; const int kr = lane >> 3, c4 = lane & 7;
#pragma unroll
    for (int i = 0; i < 8; ++i) wv[i] = __builtin_nontemporal_load((const GAS f32x4*)(W + (size_t)(k0 + 8 * i + kr) * ldw + n0 + 4 * c4));
    if (rowscale) {
#pragma unroll
        for (int i = 0; i < 8; ++i) wv[i] = wv[i] * rowscale[k0 + 8 * i + kr];
    }
#pragma unroll
    for (int i = 0; i < 8; ++i) { LAS float* d = scr + (8 * i + kr) * 33 + 4 * c4; d[0] = wv[i].x; d[1] = wv[i].y; d[2] = wv[i].z; d[3] = wv[i].w; }
    LDS_WAIT(); asm volatile("" ::: "memory");
    const int c = lane & 7;
#pragma unroll
    for (int j = 0; j < 4; ++j) { const int n = (lane >> 3) + 8 * j; const LAS float* s = scr + (8 * c) * 33 + n;
        v4u o; o.x = pk2(s[0 * 33], s[1 * 33]); o.y = pk2(s[2 * 33], s[3 * 33]); o.z = pk2(s[4 * 33], s[5 * 33]); o.w = pk2(s[6 * 33], s[7 * 33]);
        const int nn = n0 + n; const int dst = mode == 1 ? virt0(nn) : (mode == 2 ? (nn + 4096) % 6144 : nn);
        *(GAS v4u*)(WT + (size_t)dst * K + k0 + 8 * c) = o; }
    LDS_WAIT(); asm volatile("" ::: "memory");
}
__device__ __forceinline__ void rms_rows2_to_bf16(const float* xrow0, const float* xrow1, const float* w, bf16* orow0, bf16* orow1, float* rs0, float* rs1, int lane) {
    const GAS f32x4* xr0 = (const GAS f32x4*)xrow0 + lane; const GAS f32x4* xr1 = (const GAS f32x4*)xrow1 + lane; const GAS f32x4* wr = (const GAS f32x4*)w + lane;
    f32x4 v0[8], v1[8]; float s0 = 0.f, s1 = 0.f;
#pragma unroll
    for (int j = 0; j < 8; ++j) { v0[j] = __builtin_nontemporal_load(xr0 + 64 * j); v1[j] = __builtin_nontemporal_load(xr1 + 64 * j); }
#pragma unroll
    for (int j = 0; j < 8; ++j) { s0 += (v0[j].x * v0[j].x + v0[j].y * v0[j].y) + (v0[j].z * v0[j].z + v0[j].w * v0[j].w); s1 += (v1[j].x * v1[j].x + v1[j].y * v1[j].y) + (v1[j].z * v1[j].z + v1[j].w * v1[j].w); }
    const float r0 = rsqrtf(wave_sum(s0) * (1.f / DM) + EPS), r1 = rsqrtf(wave_sum(s1) * (1.f / DM) + EPS);
    if (lane == 0) { *rs0 = r0; *rs1 = r1; }
    GAS v2u* o0 = (GAS v2u*)orow0 + lane; GAS v2u* o1 = (GAS v2u*)orow1 + lane;
#pragma unroll
    for (int j = 0; j < 8; ++j) { const f32x4 ww = wr[64 * j]; v2u a, b;
        a.x = pk2(v0[j].x * r0 * ww.x, v0[j].y * r0 * ww.y); a.y = pk2(v0[j].z * r0 * ww.z, v0[j].w * r0 * ww.w); o0[64 * j] = a;
        b.x = pk2(v1[j].x * r1 * ww.x, v1[j].y * r1 * ww.y); b.y = pk2(v1[j].z * r1 * ww.z, v1[j].w * r1 * ww.w); o1[64 * j] = b; }
}

__device__ __forceinline__ void unpack8(const v4u x, float (&f)[8]) { f[0] = bflo(x.x); f[1] = bfhi(x.x); f[2] = bflo(x.y); f[3] = bfhi(x.y); f[4] = bflo(x.z); f[5] = bfhi(x.z); f[6] = bflo(x.w); f[7] = bfhi(x.w); }
__device__ __forceinline__ void conv_fix_panel(const float* HA, const float* HB, const float* wconv, bf16* Y, int pm, int tid) {
    if ((pm & 31) == 0) return;
    const int e0 = tid * 4;
    const f32x4 bz0 = *(const GAS f32x4*)(HA + ((size_t)pm * 4 + 0) * 2048 + e0), bz1 = *(const GAS f32x4*)(HA + ((size_t)pm * 4 + 1) * 2048 + e0);
    const f32x4 cu0 = *(const GAS f32x4*)(HA + ((size_t)pm * 4 + 2) * 2048 + e0), cu1 = *(const GAS f32x4*)(HA + ((size_t)pm * 4 + 3) * 2048 + e0);
    const f32x4 cm2 = *(const GAS f32x4*)(HB + ((size_t)(pm - 1) * 2 + 0) * 2048 + e0), cm1 = *(const GAS f32x4*)(HB + ((size_t)(pm - 1) * 2 + 1) * 2048 + e0);
    f32x4 w0, w1, w2;
#pragma unroll
    for (int j = 0; j < 4; ++j) { w0[j] = wconv[(e0 + j) * 3 + 0]; w1[j] = wconv[(e0 + j) * 3 + 1]; w2[j] = wconv[(e0 + j) * 3 + 2]; }
    const f32x4 y0 = bz0 * (w0 * cm2 + w1 * cm1 + w2 * cu0), y1 = bz1 * (w0 * cm1 + w1 * cu0 + w2 * cu1);
    *(GAS v2u*)(Y + (size_t)(pm * 256) * 2048 + e0) = (v2u){pk2(y0[0], y0[1]), pk2(y0[2], y0[3])};
    *(GAS v2u*)(Y + (size_t)(pm * 256 + 1) * 2048 + e0) = (v2u){pk2(y1[0], y1[1]), pk2(y1[2], y1[3])};
}

__device__ __forceinline__ void gklr_phase(LAS unsigned char* lds, const bf16* X1B, const bf16* WGT, const float* sumsq1, float* GKLR, int G, int rg0, int wave, int lane) {
    const int r = lane & 15, q = lane >> 4, kh = wave & 1;
    for (int rg = rg0 + (wave >> 1); rg - (wave >> 1) < M / 16; rg += G * 4) {
        const int row0 = rg * 16; const bool live = rg < M / 16;
        f32x4 acc = {0.f, 0.f, 0.f, 0.f};
        if (live) {
            const GAS bf16x8* ap = (const GAS bf16x8*)(X1B + (size_t)(row0 + r) * 2048 + 1024 * kh + 8 * q);
            const GAS bf16x8* bp = (const GAS bf16x8*)(WGT + (size_t)r * 2048 + 1024 * kh + 8 * q);
#pragma unroll 8
            for (int s = 0; s < 32; ++s) acc = MFMA16(__builtin_nontemporal_load(ap + 4 * s), bp[4 * s], acc);
        }
        if (kh) *(LAS f32x4*)(lds + ((wave >> 1) * 64 + lane) * 16) = acc;
        WG_BAR();
        if (!kh && live) { acc = acc + *(const LAS f32x4*)(lds + ((wave >> 1) * 64 + lane) * 16);
#pragma unroll
            for (int j = 0; j < 4; ++j) { const int row = row0 + 4 * q + j; GKLR[(size_t)row * 16 + r] = acc[j] * rsqrtf(sumsq1[row] * (1.f / DM) + EPS); } }
        WG_BAR();
    }
}

constexpr int P5_QS = 0, P5_KS = 33792, P5_KST = 67584, P5_PS = 104448, P5_GLR = 113664, P5_TOT = 117760;
__device__ __forceinline__ float logsig(float x) { return fminf(x, 0.f) - __logf(1.f + __expf(-fabsf(x))); }
__device__ __forceinline__ void gate_phase(LAS unsigned char* lds, const bf16* QK, const bf16* V, const float* GKLR, const float* wgk2, const float* bgk2,
                                           bf16* QF, bf16* KF, bf16* PF, bf16* VF, float* EB, int G, int vid, int qpm, int tid, int wave, int lane) {
    const int r = lane & 15, q = lane >> 4;
#define P5_ITEM(ITEM0) (qpm >= 0 ? ((4 * (qpm & 31) + 3 - ((ITEM0) >> 8)) << 3) | (4 * (qpm >> 5) + (vid >> 6)) : ((1023 - (ITEM0)) ^ 7))
    unsigned qx[16], kx[16]; float wA[16], wB[16]; f32x2 bias = {0.f, 0.f}; int hprev = -1;
    const int dp = tid & 127, tq = tid >> 7, d0 = 2 * dp;
#define P5_FETCH(ITEM0) do { const int item_ = P5_ITEM(ITEM0); const int bh_ = item_ & 7, c_ = item_ >> 3; const int rb_ = (bh_ >> 2) * TSEQ + c_ * CH, kc_ = (bh_ & 3) * DK + d0; \
        _Pragma("unroll") for (int i = 0; i < 16; ++i) { const size_t ro = (size_t)(rb_ + 16 * tq + i) * 2048 + kc_; \
            qx[i] = __builtin_nontemporal_load((const GAS unsigned*)(QK + ro)); kx[i] = __builtin_nontemporal_load((const GAS unsigned*)(QK + ro + 1024)); } } while (0)
    if (vid < 1024) P5_FETCH(vid);
    for (int item0 = vid; item0 < 1024; item0 += G) {
        const int item = P5_ITEM(item0);
        const int bh = item & 7, c = item >> 3, b = bh >> 2, h = bh & 3; const size_t it = (size_t)bh * NCH + c; const int rowbase = b * TSEQ + c * CH;
        if (tid < 256) { const int t = tid >> 2, r4 = tid & 3; *(LAS f32x4*)(lds + P5_GLR + t * 64 + r4 * 16) = *(const GAS f32x4*)(GKLR + (size_t)(rowbase + t) * 16 + 4 * r4); }
        const int kc = h * DK + d0;
        if (h != hprev) {
#pragma unroll
            for (int rr = 0; rr < 16; ++rr) { const f32x2 w = *(const GAS f32x2*)(wgk2 + rr * 1024 + kc); wA[rr] = w.x; wB[rr] = w.y; }
            bias = *(const GAS f32x2*)(bgk2 + kc); hprev = h; }
        WG_BAR();
        float blA[16], blB[16]; float cumA = 0.f, cumB = 0.f;
#pragma unroll
        for (int i = 0; i < 16; ++i) { const LAS f32x4* gp = (const LAS f32x4*)(lds + P5_GLR + (16 * tq + i) * 64);
            float la = bias.x, lb = bias.y;
#pragma unroll
            for (int r4 = 0; r4 < 4; ++r4) { const f32x4 g = gp[r4];
                la += g.x * wA[4 * r4] + g.y * wA[4 * r4 + 1] + g.z * wA[4 * r4 + 2] + g.w * wA[4 * r4 + 3];
                lb += g.x * wB[4 * r4] + g.y * wB[4 * r4 + 1] + g.z * wB[4 * r4 + 2] + g.w * wB[4 * r4 + 3]; }
            cumA += logsig(la) * 0.0625f; cumB += logsig(lb) * 0.0625f; blA[i] = cumA; blB[i] = cumB; }
        *(LAS f32x2*)(lds + P5_TOT + (tq * 256 + d0) * 4) = (f32x2){cumA, cumB};
        WG_BAR();
        float offA = 0.f, offB = 0.f, lastA = 0.f, lastB = 0.f;
#pragma unroll
        for (int k = 0; k < 4; ++k) { const f32x2 tt = *(const LAS f32x2*)(lds + P5_TOT + (k * 256 + d0) * 4); if (k < tq) { offA += tt.x; offB += tt.y; } lastA += tt.x; lastB += tt.y; }
        if (tq == 0) *(GAS f32x2*)(EB + it * 256 + d0) = (f32x2){__expf(lastA), __expf(lastB)};
        unsigned kw[16];
#pragma unroll
        for (int i = 0; i < 16; ++i) { const int t = 16 * tq + i; const float bA = offA + blA[i], bB = offB + blB[i];
            const float eA = __expf(bA), eB = __expf(bB), nA = __expf(-bA), nB = __expf(-bB);
            *(LAS unsigned*)(lds + P5_QS + t * 528 + d0 * 2) = pk2(bflo(qx[i]) * eA, bfhi(qx[i]) * eB);
            kw[i] = pk2(bflo(kx[i]) * nA, bfhi(kx[i]) * nB);
            *(LAS unsigned*)(lds + P5_KS + t * 528 + d0 * 2) = kw[i]; }
        if (item0 + G < 1024) P5_FETCH(item0 + G);
#pragma unroll
        for (int g = 0; g < 2; ++g) { v4u lo, hi;
#pragma unroll
            for (int k = 0; k < 4; ++k) { const unsigned a = kw[8 * g + 2 * k], bb = kw[8 * g + 2 * k + 1]; lo[k] = (a & 0xffffu) | (bb << 16); hi[k] = (a >> 16) | (bb & 0xffff0000u); }
            *(LAS v4u*)(lds + P5_KST + d0 * 144 + (16 * tq + 8 * g) * 2) = lo; *(LAS v4u*)(lds + P5_KST + (d0 + 1) * 144 + (16 * tq + 8 * g) * 2) = hi; }
        WG_BAR();
#pragma unroll
        for (int k = 0; k < 2; ++k) { const int tl = 2 * wave + k, mt = tl >> 2, nt = tl & 3; f32x4 acc = {0.f, 0.f, 0.f, 0.f};
            if (nt <= mt) {
#pragma unroll
                for (int s = 0; s < 8; ++s) { const bf16x8 qf = *(const LAS bf16x8*)(lds + P5_QS + (16 * mt + r) * 528 + (32 * s + 8 * q) * 2);
                    const bf16x8 kf = *(const LAS bf16x8*)(lds + P5_KS + (16 * nt + r) * 528 + (32 * s + 8 * q) * 2);
                    acc = MFMA16(kf, qf, acc); }
            }
            const int i_ = 16 * mt + r, j0 = 16 * nt + 4 * q; float p[4];
#pragma unroll
            for (int jj = 0; jj < 4; ++jj) p[jj] = (j0 + jj <= i_) ? acc[jj] : 0.f;
            *(LAS v2u*)(lds + P5_PS + i_ * 144 + j0 * 2) = (v2u){pk2(p[0], p[1]), pk2(p[2], p[3])}; }
#pragma unroll
        for (int i = 0; i < 4; ++i) { const int blk = wave * 4 + i, mt = blk >> 3, s = blk & 7;
            const v4u f = *(const LAS v4u*)(lds + P5_QS + (16 * mt + r) * 528 + (32 * s + 8 * q) * 2);
            *(GAS v4u*)(QF + (it * 32 + blk) * 512 + lane * 8) = f; }
#pragma unroll
        for (int i = 0; i < 4; ++i) { const int blk = wave * 4 + i, md = blk >> 1, s = blk & 1;
            const v4u f = *(const LAS v4u*)(lds + P5_KST + (16 * md + r) * 144 + (32 * s + 8 * q) * 2);
            *(GAS v4u*)(KF + (it * 32 + blk) * 512 + lane * 8) = f; }
        WG_BAR();
        { const int mt = wave >> 1, s = wave & 1;
          const v4u f = *(const LAS v4u*)(lds + P5_PS + (16 * mt + r) * 144 + (32 * s + 8 * q) * 2);
          *(GAS v4u*)(PF + (it * 8 + wave) * 512 + lane * 8) = f; }
        WG_BAR();
    }
}

struct ULd { bf16x8 vfn; bf16x8 kf[2][2]; f32x4 eb[2]; };
struct OLd { bf16x8 qf[4]; bf16x8 pf; };
__device__ __forceinline__ void u_load(ULd& L, const bf16* KF, const bf16* VF, const float* EB, size_t it, int ne2, int dh, int w, int lane) {
    L.vfn = __builtin_nontemporal_load((const GAS bf16x8*)(VF + (it * 64 + ne2 * 4 + w) * 512) + lane);
    const GAS bf16x8* kp = (const GAS bf16x8*)(KF + (it * 32 + 16 * dh + 4 * w) * 512) + lane;
#pragma unroll
    for (int i = 0; i < 2; ++i)
#pragma unroll
        for (int s = 0; s < 2; ++s) L.kf[i][s] = kp[(2 * i + s) * 64];
    const GAS f32x4* ep = (const GAS f32x4*)(EB + it * 256 + 128 * dh + 32 * w + 4 * (lane >> 4));
#pragma unroll
    for (int i = 0; i < 2; ++i) L.eb[i] = ep[4 * i];
}
__device__ __forceinline__ void o_load(OLd& L, const bf16* QF, const bf16* PF, size_t it, int dh, int mt, int lane) {
    const GAS bf16x8* qp = (const GAS bf16x8*)(QF + (it * 32 + 8 * mt + 4 * dh) * 512) + lane;
#pragma unroll
    for (int s = 0; s < 4; ++s) L.qf[s] = qp[s * 64];
    L.pf = *((const GAS bf16x8*)(PF + (it * 8 + 2 * mt + dh) * 512) + lane);
}
constexpr int SB_STRIDE = 272, SB_BYTES = 32 * SB_STRIDE;
constexpr int VFB_OFF = 2 * SB_BYTES, VFB_BYTES = 4096;
__device__ __forceinline__ void u_step(const ULd& L, const ULd& Ln, f32x4 (&S)[2][2], LAS unsigned char* sb_nxt, const LAS unsigned char* vfb_cur, LAS unsigned char* vfb_nxt, int w, int lane) {
    const int c = lane & 15, q = lane >> 4;
    bf16x8 vf[2][2];
#pragma unroll
    for (int et = 0; et < 2; ++et)
#pragma unroll
        for (int s = 0; s < 2; ++s) vf[et][s] = *(const LAS bf16x8*)(vfb_cur + ((2 * et + s) * 64 + lane) * 16);
    *(LAS bf16x8*)(vfb_nxt + (w * 64 + lane) * 16) = Ln.vfn;
#pragma unroll
    for (int i = 0; i < 2; ++i)
#pragma unroll
        for (int et = 0; et < 2; ++et) {
            S[et][i] = MFMA16(L.kf[i][0], vf[et][0], S[et][i]); S[et][i] = MFMA16(L.kf[i][1], vf[et][1], S[et][i]);
        }
#pragma unroll
    for (int i = 0; i < 2; ++i)
#pragma unroll
        for (int et = 0; et < 2; ++et) {
            S[et][i] = S[et][i] * L.eb[i];
            *(LAS v2u*)(sb_nxt + (16 * et + c) * SB_STRIDE + (32 * w + 16 * i + 4 * q) * 2) = (v2u){pk2(S[et][i][0], S[et][i][1]), pk2(S[et][i][2], S[et][i][3])};
        }
    WG_BAR();
}
__device__ __forceinline__ void o_step(const OLd& L, const LAS unsigned char* sb_cur, const LAS unsigned char* vfb_cur, bf16* O, int row0, int col0, int dh, int lane) {
    const int c = lane & 15, q = lane >> 4;
    f32x4 acc[2];
    acc[0] = (f32x4){0.f, 0.f, 0.f, 0.f}; acc[1] = acc[0];
#pragma unroll
    for (int s = 0; s < 4; ++s)
#pragma unroll
        for (int et = 0; et < 2; ++et) { const bf16x8 sf = *(const LAS bf16x8*)(sb_cur + (16 * et + c) * SB_STRIDE + (32 * s + 8 * q) * 2); acc[et] = MFMA16(sf, L.qf[s], acc[et]); }
#pragma unroll
    for (int et = 0; et < 2; ++et) { const bf16x8 vf = *(const LAS bf16x8*)(vfb_cur + ((2 * et + dh) * 64 + lane) * 16); acc[et] = MFMA16(vf, L.pf, acc[et]); }
    const int row = row0 + c;
    v4u w;
    asm volatile("s_nop 7\n\ts_nop 3\n\tv_cvt_pk_bf16_f32 %0, %4, %5\n\tv_cvt_pk_bf16_f32 %1, %6, %7\n\tv_cvt_pk_bf16_f32 %2, %8, %9\n\tv_cvt_pk_bf16_f32 %3, %10, %11"
                 : "=&v"(w.x), "=&v"(w.y), "=&v"(w.z), "=&v"(w.w)
                 : "v"(acc[0][0]), "v"(acc[0][1]), "v"(acc[0][2]), "v"(acc[0][3]), "v"(acc[1][0]), "v"(acc[1][1]), "v"(acc[1][2]), "v"(acc[1][3]));
    *(GAS v4u*)(O + (size_t)row * 2048 + col0 + 8 * q) = w;
    WG_BAR();
}
__device__ __forceinline__ void scan_phase(LAS unsigned char* lds, const bf16* QF, const bf16* KF, const bf16* PF, const bf16* VF, const float* EB, bf16* O0, bf16* O1, int G, int vid, int tid, int wave, int lane) {
    for (int item = vid; item < 256; item += G) {
        const int bh = item & 7, dh = (item >> 3) & 1, ne2 = item >> 4, b = bh >> 2, h = bh & 3; const size_t it0 = (size_t)bh * NCH;
        for (int i = tid; i < 2 * SB_BYTES / 4; i += 512) ((LAS unsigned*)lds)[i] = 0u;
        LAS unsigned char* vfb = lds + VFB_OFF;
        if (wave < 4) {
            f32x4 S[2][2];
#pragma unroll
            for (int et = 0; et < 2; ++et)
#pragma unroll
                for (int i = 0; i < 2; ++i) S[et][i] = (f32x4){0.f, 0.f, 0.f, 0.f};
            ULd A, B, C; u_load(A, KF, VF, EB, it0, ne2, dh, wave, lane); u_load(B, KF, VF, EB, it0 + 1, ne2, dh, wave, lane);
            *(LAS bf16x8*)(vfb + (wave * 64 + lane) * 16) = A.vfn;
            WG_BAR();
            int c = 0;
            for (; c < NCH - 2; c += 3) {
                u_load(C, KF, VF, EB, it0 + c + 2, ne2, dh, wave, lane);
                u_step(A, B, S, lds + ((c + 1) & 1) * SB_BYTES, vfb + (c & 1) * VFB_BYTES, vfb + ((c + 1) & 1) * VFB_BYTES, wave, lane);
                u_load(A, KF, VF, EB, it0 + c + 3, ne2, dh, wave, lane);
                u_step(B, C, S, lds + (c & 1) * SB_BYTES, vfb + ((c + 1) & 1) * VFB_BYTES, vfb + (c & 1) * VFB_BYTES, wave, lane);
                u_load(B, KF, VF, EB, it0 + (c + 4 < NCH ? c + 4 : NCH - 1), ne2, dh, wave, lane);
                u_step(C, A, S, lds + ((c + 1) & 1) * SB_BYTES, vfb + (c & 1) * VFB_BYTES, vfb + ((c + 1) & 1) * VFB_BYTES, wave, lane);
            }
            u_step(A, B, S, lds + ((c + 1) & 1) * SB_BYTES, vfb + (c & 1) * VFB_BYTES, vfb + ((c + 1) & 1) * VFB_BYTES, wave, lane);
            u_step(B, B, S, lds + (c & 1) * SB_BYTES, vfb + ((c + 1) & 1) * VFB_BYTES, vfb + (c & 1) * VFB_BYTES, wave, lane);
        } else {
            const int mt = wave - 4, col0 = h * DV + 32 * ne2, rb = b * TSEQ + 16 * mt; bf16* O = dh ? O1 : O0;
            OLd A, B, C; o_load(A, QF, PF, it0, dh, mt, lane); o_load(B, QF, PF, it0 + 1, dh, mt, lane);
            WG_BAR();
            int c = 0;
            for (; c < NCH - 2; c += 3) {
                o_load(C, QF, PF, it0 + c + 2, dh, mt, lane);
                o_step(A, lds + (c & 1) * SB_BYTES, vfb + (c & 1) * VFB_BYTES, O, rb + c * CH, col0, dh, lane);
                o_load(A, QF, PF, it0 + c + 3, dh, mt, lane);
                o_step(B, lds + ((c + 1) & 1) * SB_BYTES, vfb + ((c + 1) & 1) * VFB_BYTES, O, rb + (c + 1) * CH, col0, dh, lane);
                o_load(B, QF, PF, it0 + (c + 4 < NCH ? c + 4 : NCH - 1), dh, mt, lane);
                o_step(C, lds + (c & 1) * SB_BYTES, vfb + (c & 1) * VFB_BYTES, O, rb + (c + 2) * CH, col0, dh, lane);
            }
            o_step(A, lds + (c & 1) * SB_BYTES, vfb + (c & 1) * VFB_BYTES, O, rb + c * CH, col0, dh, lane);
            o_step(B, lds + ((c + 1) & 1) * SB_BYTES, vfb + ((c + 1) & 1) * VFB_BYTES, O, rb + (c + 1) * CH, col0, dh, lane);
        }
        WG_BAR();
    }
}

__device__ __forceinline__ void outgate_phase(bf16* O, const bf16* O1, const bf16* Gt, const float* gnw, int gw, int NGW, int lane) {
    const f32x4 w0 = *(const GAS f32x4*)(gnw + lane * 8), w1 = *(const GAS f32x4*)(gnw + lane * 8 + 4);
    const float w[8] = {w0.x, w0.y, w0.z, w0.w, w1.x, w1.y, w1.z, w1.w};
    for (int m = gw; m < M / 2; m += NGW) {
        v4u ov[2][4], pv[2][4], gv[2][4];
#pragma unroll
        for (int rr = 0; rr < 2; ++rr)
#pragma unroll
            for (int j = 0; j < 4; ++j) { const size_t off = (size_t)(m + rr * (M / 2)) * 2048 + 512 * j + 8 * lane; ov[rr][j] = *(const GAS v4u*)(O + off); pv[rr][j] = *(const GAS v4u*)(O1 + off); gv[rr][j] = *(const GAS v4u*)(Gt + off); }
#pragma unroll
        for (int rr = 0; rr < 2; ++rr)
#pragma unroll
            for (int j = 0; j < 4; ++j) {
                float o[8], o1[8], g[8], y[8]; unpack8(ov[rr][j], o); unpack8(pv[rr][j], o1); unpack8(gv[rr][j], g);
#pragma unroll
                for (int i = 0; i < 8; ++i) o[i] += o1[i];
                float ss = 0.f;
#pragma unroll
                for (int i = 0; i < 8; ++i) ss += o[i] * o[i];
                const float rs = rsqrtf(wave_sum(ss) * (1.f / DV) + EPS);
#pragma unroll
                for (int i = 0; i < 8; ++i) y[i] = o[i] * rs * w[i] * g[i] * __builtin_amdgcn_rcpf(1.f + __expf(-g[i]));
                v4u r; r.x = pk2(y[0], y[1]); r.y = pk2(y[2], y[3]); r.z = pk2(y[4], y[5]); r.w = pk2(y[6], y[7]);
                *(GAS v4u*)(O + (size_t)(m + rr * (M / 2)) * 2048 + 512 * j + 8 * lane) = r;
            }
    }
}
__device__ __forceinline__ void final_norm_phase(const bf16* X2, float* out, const float* sumsq2, const float* w, int gt, int NT) {
    const f32x4 wa = *(const GAS f32x4*)(w + (gt & 255) * 8), wb = *(const GAS f32x4*)(w + (gt & 255) * 8 + 4);
    for (int p0 = gt; p0 < M * 256; p0 += 8 * NT) {
        v4u xv[8]; float ss[8];
#pragma unroll
        for (int k = 0; k < 8; ++k) { const int p = p0 + k * NT; if (p < M * 256) { xv[k] = __builtin_nontemporal_load((const GAS v4u*)(X2 + (size_t)p * 8)); ss[k] = sumsq2[p >> 8]; } }
#pragma unroll
        for (int k = 0; k < 8; ++k) { const int p = p0 + k * NT; if (p < M * 256) { const float rs = rsqrtf(ss[k] * (1.f / DM) + EPS); float x[8]; unpack8(xv[k], x);
            *(GAS f32x4*)(out + (size_t)p * 8) = (f32x4){x[0] * rs * wa.x, x[1] * rs * wa.y, x[2] * rs * wa.z, x[3] * rs * wa.w};
            *(GAS f32x4*)(out + (size_t)p * 8 + 4) = (f32x4){x[4] * rs * wb.x, x[5] * rs * wb.y, x[6] * rs * wb.z, x[7] * rs * wb.w}; } }
    }
}
#ifndef REP_P0
#define REP_P0 1
#endif
#ifndef REP_P1
#define REP_P1 1
#endif
#ifndef REP_P2
#define REP_P2 1
#endif
#ifndef REP_P5
#define REP_P5 1
#endif
#ifndef REP_P6
#define REP_P6 1
#endif
#ifndef REP_P4
#define REP_P4 1
#endif
#ifndef USE_XCD_BAR
#define USE_XCD_BAR 1
#endif
struct Args { const float* in[12]; float* out; unsigned char* ws; };
__global__ void __launch_bounds__(NWAVES * 64, 2) hybrid_fwd(Args a) {
    extern __shared__ __attribute__((aligned(16))) unsigned char lds_raw[];
    LAS unsigned char* lds = (LAS unsigned char*)lds_raw;
    cg::grid_group grid = cg::this_grid();
    const int tid = threadIdx.x, lane = tid & 63, wave = __builtin_amdgcn_readfirstlane(tid >> 6);
    const int G = gridDim.x, gw = blockIdx.x * NWAVES + wave, NGW = G * NWAVES, gt = blockIdx.x * (NWAVES * 64) + tid, NT = G * NWAVES * 64;
    unsigned char* ws = a.ws;
    const float* x = a.in[0]; const float* norm0_w = a.in[1]; const float* w_in0 = a.in[2]; const float* w_conv = a.in[3]; const float* w_out0 = a.in[4];
    const float* norm1_w = a.in[5]; const float* w_in1 = a.in[6]; const float* w_gk2 = a.in[7]; const float* b_gk2 = a.in[8]; const float* gn_w = a.in[9]; const float* w_out1 = a.in[10]; const float* normf_w = a.in[11];
    float* sumsq1 = (float*)(ws + WS_SUMSQ1); float* sumsq2 = (float*)(ws + WS_SUMSQ2); float* hsum = (float*)(ws + WS_HSUM);
    float* rstd0 = (float*)(ws + WS_RSTD0); float* gklr = (float*)(ws + WS_GKLR); float* eb = (float*)(ws + WS_EB);
    bf16* wgt = (bf16*)(ws + WS_WGT); bf16* w0t = (bf16*)(ws + WS_W0T); bf16* wo0t = (bf16*)(ws + WS_WO0T); bf16* w1t = (bf16*)(ws + WS_W1T); bf16* wo1t = (bf16*)(ws + WS_WO1T);
    bf16* bufA = (bf16*)(ws + WS_BUFA); bf16* bufB = (bf16*)(ws + WS_BUFB); bf16* bufC = (bf16*)(ws + WS_BUFC); bf16* bufD = (bf16*)(ws + WS_BUFD);
    bf16* x1b = (bf16*)(ws + WS_X1);
    bf16* vf = (bf16*)(ws + WS_VF); bf16* qf = bufC; bf16* kf = bufC + (size_t)16 * 1024 * 1024; bf16* pf = (bf16*)(ws + WS_PF);
#if USE_XCD_BAR
    volatile LAS unsigned* misc = (volatile LAS unsigned*)(lds + LDS_BYTES - 64);
    unsigned* ctlw = (unsigned*)(ws + WS_CTL);
    constexpr int CW_PROG = 8192;
    constexpr int CW_XQID = 12288, CW_BAD = 12800, CW_QCNT = 16384;
    if (tid == 0) { misc[0] = 0u; misc[1] = 0u; __hip_atomic_store(ctlw + CW_XQID + blockIdx.x, xb_xcc_id() + 1u, __ATOMIC_RELAXED, __HIP_MEMORY_SCOPE_AGENT); }
    __syncthreads();
    XcdBarrier xbar = xcd_barrier_post((unsigned*)(ws + WS_CTL) + 1024, (volatile LAS unsigned*)(lds + LDS_BYTES - 64));
    if (a.ws == nullptr) grid.sync();
#define GRID_BAR() xcd_barrier(xbar)
#else
#define GRID_BAR() grid.sync()
#endif

    for (int rep = 0; rep < REP_P0; ++rep) {
        LAS float* scr = (LAS float*)(lds + wave * 16384);
        constexpr int I0 = 32 * 256, IO = 32 * 64, I1 = 32 * 192, NITEMS = I0 + IO + I1 + IO;
        for (int it = gw; it < NITEMS; it += NGW) {
            int r = it;
            if (r < IO) { p0_transpose_item(w_out1, DM, 64, DM, wo1t, 0, nullptr, scr, r, lane); continue; } r -= IO;
            if (r < I1) { p0_transpose_item(w_in1, N1RAW, 192, DM, w1t, 2, norm1_w, scr, r, lane); continue; } r -= I1;
            if (r < IO) { p0_transpose_item(w_out0, DM, 64, DM, wo0t, 0, nullptr, scr, r, lane); continue; } r -= IO;
            p0_transpose_item(w_in0, N0, 256, DM, w0t, 1, nullptr, scr, r, lane);
        }
        for (int p = gt; p < 16 * DM; p += NT) { const int n = p >> 11, k = p & (DM - 1); wgt[p] = (bf16)(pk2(w_in1[(size_t)k * N1RAW + N1 + n] * norm1_w[k], 0.f) & 0xffffu); }
        for (int m = gw; m < M / 2; m += NGW) rms_rows2_to_bf16(x + (size_t)m * DM, x + (size_t)(m + M / 2) * DM, norm0_w, bufA + (size_t)m * DM, bufA + (size_t)(m + M / 2) * DM, rstd0 + m, rstd0 + m + M / 2, lane);
    }
    GRID_BAR();
    const int vid = (int)blockIdx.x;
    if (tid == 0) { bool ok = (G == 256);
        if (ok) { const unsigned a0 = xb_ld(ctlw + CW_XQID + (vid & 63)), a1 = xb_ld(ctlw + CW_XQID + (vid & 63) + 64), a2 = xb_ld(ctlw + CW_XQID + (vid & 63) + 128), a3 = xb_ld(ctlw + CW_XQID + (vid & 63) + 192);
                  ok = (a0 != 0u) && a0 == a1 && a1 == a2 && a2 == a3; }
        if (!ok) xb_add(ctlw + CW_BAD, 1u); }
    for (int rep = 0; rep < REP_P1; ++rep) {
        pg8::Gemm g{bufA, w0t, M, N0, DM}; pg8::StaticOrder S; S.init(M, N0, G, vid);
        pg8::EpiConvFused E{bufB, w_conv, (float*)(ws + WS_HA), (float*)(ws + WS_HB), (LAS float*)(lds + 131072)};
        pg8::gemm_phase<pg8::EpiConvFused, pg8::StaticOrder, true, true>(lds, g, S, E);
    }
    GRID_BAR();
    if (tid == 0) misc[5] = (xb_ld(ctlw + CW_BAD) == 0u) ? 1u : 0u;
    __syncthreads();
    const bool quadmode = __builtin_amdgcn_readfirstlane((int)misc[5]) != 0;
    unsigned* qcnt = ctlw + CW_QCNT + 64 * (vid & 63); unsigned qgen = 0u;
    int qpm = -1; if (quadmode) { pg8::StaticOrder S; S.init(M, DM, G, vid); pg8::Unit u0; (void)S.next(0, u0); qpm = u0.pm; }
#define QUAD_OR_GRID_BAR() do { if (quadmode) { \
        asm volatile("s_waitcnt vmcnt(0)" ::: "memory"); __syncthreads(); \
        if (tid == 0) { (void)xb_add(qcnt, 1u); const unsigned want_ = 4u * (qgen + 1u); unsigned sp_ = 0u; \
            while (xb_ld(qcnt) < want_) { __builtin_amdgcn_s_sleep(1); if (++sp_ > (1u << 22)) break; } \
            __builtin_amdgcn_fence(__ATOMIC_ACQUIRE, "agent"); asm volatile("s_waitcnt vmcnt(0)" ::: "memory"); } \
        ++qgen; __syncthreads(); } else { GRID_BAR(); } } while (0)
    {
        pg8::Gemm g{bufB, wo0t, M, DM, DM}; pg8::StaticOrder S; S.init(M, DM, G, vid);
        { pg8::Unit uu; int last = -1;
          for (int i = 0; S.next(i, uu); ++i) if (uu.pm != last) { conv_fix_panel((const float*)(ws + WS_HA), (const float*)(ws + WS_HB), w_conv, bufB, uu.pm, tid); last = uu.pm; }
          asm volatile("s_waitcnt vmcnt(0)" ::: "memory"); __syncthreads(); }
        pg8::EpiResid<2> E{bufA, x1b, sumsq1, rstd0, norm0_w};
        pg8::gemm_phase<pg8::EpiResid<2>, pg8::StaticOrder, true, true>(lds, g, S, E);
    }
    QUAD_OR_GRID_BAR();
    for (int rep = 0; rep < REP_P4; ++rep) {
        pg8::Gemm g{x1b, w1t, M, N1, DM}; pg8::StaticOrder S; S.init(M, N1, G, vid);
        pg8::EpiQKVG E{bufA, (long)((WS_BUFD - WS_BUFA) / 2), vf, sumsq1, lds + 133120};
        pg8::gemm_phase<pg8::EpiQKVG, pg8::StaticOrder, true, true>(lds, g, S, E);
        { pg8::Unit u0; (void)S.next(0, u0); gklr_phase(lds, x1b, wgt, sumsq1, gklr, G, quadmode ? 16 * u0.pm + 4 * (vid >> 6) : (int)blockIdx.x * 4, wave, lane); }
    }
    QUAD_OR_GRID_BAR();
    for (int rep = 0; rep < REP_P5; ++rep) gate_phase(lds, bufA, bufC, gklr, w_gk2, b_gk2, qf, kf, pf, vf, eb, G, vid, qpm, tid, wave, lane);
    GRID_BAR();
    scan_phase(lds, qf, kf, pf, vf, eb, bufA, bufB, G, vid, tid, wave, lane);
    GRID_BAR();
    outgate_phase(bufA, bufB, bufD, gn_w, gw, NGW, lane);
    GRID_BAR();
    {
        pg8::Gemm g{bufA, wo1t, M, DM, DM}; pg8::StaticOrder S; S.init(M, DM, G, vid);
        pg8::EpiResid<1> E{x1b, bufB, sumsq2, nullptr, nullptr};
        pg8::gemm_phase<pg8::EpiResid<1>, pg8::StaticOrder, true, true>(lds, g, S, E);
    }
    GRID_BAR();
    final_norm_phase(bufB, a.out, sumsq2, normf_w, gt, NT);
}

extern "C" void kernel_launch(void* const* d_in, const int* in_sizes, int n_in, void* d_out, int out_size, void* d_ws, size_t ws_size, hipStream_t stream) {
    static int grid = 0;
    if (grid == 0) {
        if (n_in != 12 || in_sizes[0] != M * DM || out_size != M * DM || ws_size < WS_END) { fprintf(stderr, "kernel_launch: unexpected shapes (n_in %d, in0 %d, out %d, ws %zu); nothing launched\n", n_in, n_in > 0 ? in_sizes[0] : -1, out_size, ws_size); grid = -1; return; }
        int dev = 0, cus = 0, per_cu = 0;
        if (hipGetDevice(&dev) != hipSuccess || hipDeviceGetAttribute(&cus, hipDeviceAttributeMultiprocessorCount, dev) != hipSuccess) { fprintf(stderr, "kernel_launch: device query failed\n"); grid = -1; return; }
        if (hipFuncSetAttribute((const void*)hybrid_fwd, hipFuncAttributeMaxDynamicSharedMemorySize, LDS_BYTES) != hipSuccess) { fprintf(stderr, "kernel_launch: hipFuncSetAttribute failed\n"); grid = -1; return; }
        if (hipOccupancyMaxActiveBlocksPerMultiprocessor(&per_cu, (const void*)hybrid_fwd, NWAVES * 64, LDS_BYTES) != hipSuccess || per_cu < 1) { fprintf(stderr, "kernel_launch: occupancy query says %d blocks per CU\n", per_cu); per_cu = 1; }
        (void)hipGetLastError();
        grid = cus * per_cu;
    }
    if (grid < 0) return;
    (void)hipMemsetAsync((char*)d_ws + WS_CTL, 0, CTL_ZERO_BYTES, stream);
    Args a{};
    for (int i = 0; i < 12; ++i) a.in[i] = (const float*)d_in[i];
    a.out = (float*)d_out; a.ws = (unsigned char*)d_ws;
    void* params[] = {&a};
    hipError_t e = hipLaunchCooperativeKernel((const void*)hybrid_fwd, dim3(grid), dim3(NWAVES * 64), params, LDS_BYTES, stream);
    if (e != hipSuccess) fprintf(stderr, "kernel_launch: cooperative launch failed: %s (grid %d)\n", hipGetErrorString(e), grid);
}
```

```cpp
#include <hip/hip_runtime.h>
#include <hip/hip_cooperative_groups.h>
#include <cstdio>
#include <cstdint>
namespace cg = cooperative_groups;
namespace pg8 {
#define PG8_LAS __attribute__((address_space(3)))
typedef unsigned short bf16_t;
typedef short bf16x8 __attribute__((ext_vector_type(8)));
typedef float f32x4 __attribute__((ext_vector_type(4)));
typedef unsigned u32x4 __attribute__((ext_vector_type(4)));
constexpr int BM = 256, BK = 64, HALF = 128, HTB = HALF * BK * 2  , STAGE_BYTES = 8 * HTB, NXCD = 8, WGM = 8;

__host__ __device__ __forceinline__ int lds_byte(int r, int c) { const int st = (r >> 4) * 2 + (c >> 5), rr = r & 15, cc = c & 31, ob = rr * 64 + cc * 2; return st * 1024 + (ob ^ (((ob >> 9) & 1) << 5)); }
__host__ __device__ __forceinline__ void stage_rc(int b, int& R, int& C) { const int st = b / 1024, sb = b % 1024, swz = sb ^ (((sb >> 9) & 1) << 5); R = (st >> 1) * 16 + swz / 64; C = (st & 1) * 32 + (swz % 64) / 2; }
__host__ __device__ __forceinline__ int perm32(int rho) { const int n = rho >> 4, i = rho & 15; return 8 * (i >> 2) + 4 * n + (i & 3); }

struct Unit { int pm, pn; };
struct Gemm { const bf16_t* A; const bf16_t* Bt; int M, N, K; };

struct StaticOrder {
    int nM, nN, nwg, G, c;
    __host__ __device__ void init(int M, int N, int G_, int c_) { nM = M / BM; nN = N / BM; nwg = nM * nN; G = G_; c = c_; }
    __host__ __device__ bool next(int i, Unit& u) const {
        const long L = (long)i * G + c; if (L >= nwg) return false;
        int wgid = (int)L; { const int q = nwg / NXCD, r = nwg % NXCD, xcd = wgid % NXCD, off = wgid / NXCD; wgid = (xcd < r ? xcd * (q + 1) : r * (q + 1) + (xcd - r) * q) + off; }
        const int nig = WGM * nN, gid = wgid / nig, fm = gid * WGM, gsz = (nM - fm) < WGM ? (nM - fm) : WGM;
        u.pm = fm + ((wgid % nig) % gsz); u.pn = (wgid % nig) / gsz; return true;
    }
    __device__ __forceinline__ void a_ready(const Unit&) const {}
    __device__ __forceinline__ void done(const Unit&) const {}
};

__device__ __forceinline__ unsigned cvt_pk_bf16(float lo, float hi) { unsigned r; asm volatile("v_cvt_pk_bf16_f32 %0, %1, %2" : "=v"(r) : "v"(lo), "v"(hi)); return r; }
typedef float f32x2 __attribute__((ext_vector_type(2)));
typedef unsigned u32x2 __attribute__((ext_vector_type(2)));
constexpr float RMS_EPS = 1e-6f;
struct EpiConvFused {
    static constexpr bool PERM = false, AFTER_DRAIN = false;
    bf16_t* Y; const float* wconv; float* HA; float* HB; PG8_LAS float* xch;
    __device__ __forceinline__ void operator()(const f32x4 (&acc)[2][2][4][2], const Unit& u, int wr, int wc, int fr, int fq) const {
        const int row0 = u.pm * BM + wr * 64 + fr; const int ch = wc * 16 + 4 * fq, e0 = u.pn * 64 + ch;
        f32x4 w0, w1, w2;
#pragma unroll
        for (int j = 0; j < 4; ++j) { w0[j] = wconv[(e0 + j) * 3 + 0]; w1[j] = wconv[(e0 + j) * 3 + 1]; w2[j] = wconv[(e0 + j) * 3 + 2]; }
#pragma unroll
        for (int ai = 0; ai < 2; ++ai) { const f32x4 cu3 = acc[ai][0][3][1] * acc[ai][1][3][0];
            if (fr >= 14) *(PG8_LAS f32x4*)(xch + ((2 * ai + wr) * 2 + (fr - 14)) * 64 + ch) = cu3; }
        asm volatile("s_waitcnt lgkmcnt(0)" ::: "memory"); __builtin_amdgcn_s_barrier(); asm volatile("" ::: "memory");
#pragma unroll
        for (int ai = 0; ai < 2; ++ai) {
            const int blk = 2 * ai + wr;
            f32x4 l14 = {0.f, 0.f, 0.f, 0.f}, l15 = {0.f, 0.f, 0.f, 0.f};
            if (blk > 0) { const f32x4 rm2 = *(const PG8_LAS f32x4*)(xch + ((blk - 1) * 2 + 0) * 64 + ch), rm1 = *(const PG8_LAS f32x4*)(xch + ((blk - 1) * 2 + 1) * 64 + ch);
                l15 = rm1; l14 = (fr == 0) ? rm2 : rm1; }
#pragma unroll
            for (int m = 0; m < 4; ++m) {
                const int row = row0 + ai * HALF + m * 16;
                const f32x4 b = acc[ai][0][m][0], c = acc[ai][0][m][1], uu = acc[ai][1][m][0], z = acc[ai][1][m][1];
                const f32x4 cu = c * uu; f32x4 bz, p1, p2;
#pragma unroll
                for (int j = 0; j < 4; ++j) {
                    bz[j] = b[j] * z[j] * __builtin_amdgcn_rcpf(1.f + __expf(-z[j]));
                    const float r1 = __int_as_float(__builtin_amdgcn_update_dpp(0, __float_as_int(cu[j]), 0x121, 0xf, 0xf, false));
                    const float r2 = __int_as_float(__builtin_amdgcn_update_dpp(0, __float_as_int(cu[j]), 0x122, 0xf, 0xf, false));
                    p1[j] = fr >= 1 ? r1 : l15[j];
                    p2[j] = fr >= 2 ? r2 : l14[j];
                    l15[j] = r1; l14[j] = r2;
                }
                const f32x4 y = bz * (w0 * p2 + w1 * p1 + w2 * cu);
                u32x2 wv; wv.x = cvt_pk_bf16(y[0], y[1]); wv.y = cvt_pk_bf16(y[2], y[3]);
                *(u32x2*)(Y + (size_t)row * 2048 + e0) = wv;
                if (blk == 0 && m == 0 && fr < 2) { *(f32x4*)(HA + ((size_t)u.pm * 4 + fr) * 2048 + e0) = bz; *(f32x4*)(HA + ((size_t)u.pm * 4 + 2 + fr) * 2048 + e0) = cu; }
                if (blk == 3 && m == 3 && fr >= 14) *(f32x4*)(HB + ((size_t)u.pm * 2 + (fr - 14)) * 2048 + e0) = cu;
            }
        }
        asm volatile("s_waitcnt lgkmcnt(0)" ::: "memory"); __builtin_amdgcn_s_barrier(); asm volatile("" ::: "memory");
    }
};
template <int BASE_MODE> struct EpiResid {
    static constexpr bool PERM = true, AFTER_DRAIN = false; static constexpr bool BASE_BF16 = BASE_MODE != 0;
    const void* base; bf16_t* outb; float* sumsq; const float* rs0; const float* nw0;
    __device__ __forceinline__ void operator()(const f32x4 (&acc)[2][2][4][2], const Unit& u, int wr, int wc, int fr, int fq) const {
        const int row0 = u.pm * BM + wr * 64 + fr; const int col0 = u.pn * BM + wc * 32 + 8 * fq;
        f32x4 iw[2][2];
        if (BASE_MODE == 2) {
#pragma unroll
            for (int bj = 0; bj < 2; ++bj)
#pragma unroll
                for (int n = 0; n < 2; ++n) { const f32x4 w = *(const f32x4*)(nw0 + col0 + bj * HALF + 4 * n);
#pragma unroll
                    for (int j = 0; j < 4; ++j) iw[bj][n][j] = __builtin_amdgcn_rcpf(w[j]); }
        }
#pragma unroll
        for (int ai = 0; ai < 2; ++ai) {
            f32x4 bv[4][2][2];
#pragma unroll
            for (int m = 0; m < 4; ++m)
#pragma unroll
                for (int bj = 0; bj < 2; ++bj) { const size_t o = (size_t)(row0 + ai * HALF + m * 16) * 2048 + col0 + bj * HALF;
                    if (BASE_BF16) { const u32x4 w = __builtin_nontemporal_load((const u32x4*)((const bf16_t*)base + o));
                        bv[m][bj][0] = (f32x4){__uint_as_float(w.x << 16), __uint_as_float(w.x & 0xffff0000u), __uint_as_float(w.y << 16), __uint_as_float(w.y & 0xffff0000u)};
                        bv[m][bj][1] = (f32x4){__uint_as_float(w.z << 16), __uint_as_float(w.z & 0xffff0000u), __uint_as_float(w.w << 16), __uint_as_float(w.w & 0xffff0000u)};
                        if (BASE_MODE == 2) { const float irs = __builtin_amdgcn_rcpf(rs0[row0 + ai * HALF + m * 16]); bv[m][bj][0] = bv[m][bj][0] * iw[bj][0] * irs; bv[m][bj][1] = bv[m][bj][1] * iw[bj][1] * irs; } }
                    else { bv[m][bj][0] = *(const f32x4*)((const float*)base + o); bv[m][bj][1] = *(const f32x4*)((const float*)base + o + 4); } }
#pragma unroll
            for (int m = 0; m < 4; ++m) {
                const int row = row0 + ai * HALF + m * 16; float s = 0.f;
#pragma unroll
                for (int bj = 0; bj < 2; ++bj) {
                    const f32x4 v0 = bv[m][bj][0] + acc[ai][bj][m][0], v1 = bv[m][bj][1] + acc[ai][bj][m][1];
                    s += ((v0[0] * v0[0] + v0[1] * v0[1]) + (v0[2] * v0[2] + v0[3] * v0[3])) + ((v1[0] * v1[0] + v1[1] * v1[1]) + (v1[2] * v1[2] + v1[3] * v1[3]));
                    u32x4 w; w.x = cvt_pk_bf16(v0[0], v0[1]); w.y = cvt_pk_bf16(v0[2], v0[3]); w.z = cvt_pk_bf16(v1[0], v1[1]); w.w = cvt_pk_bf16(v1[2], v1[3]);
                    *(u32x4*)(outb + (size_t)row * 2048 + col0 + bj * HALF) = w;
                }
                s += __shfl_xor(s, 16); s += __shfl_xor(s, 32);
                if (fq == 0) unsafeAtomicAdd(sumsq + row, s);
            }
            asm volatile("" ::: "memory");
        }
    }
};
struct EpiQKVG {
    static constexpr bool PERM = true, AFTER_DRAIN = false;
    bf16_t* QK; long dG; bf16_t* VFp; const float* sumsq1; PG8_LAS unsigned char* scr;
    __device__ __forceinline__ void operator()(const f32x4 (&acc)[2][2][4][2], const Unit& u, int wr, int wc, int fr, int fq) const {
        const int row0 = u.pm * BM + wr * 64 + fr; const int sel = u.pn < 8 ? 1 : (u.pn < 16 ? 2 : 0);
        const int col0 = (u.pn & 7) * BM + wc * 32 + 8 * fq; const float sc0 = (u.pn >= 16 && u.pn < 20) ? 0.0625f : 1.0f;
        if (sel != 1) {
            bf16_t* basep = QK + (sel >= 2 ? dG : 0L);
#pragma unroll
            for (int ai = 0; ai < 2; ++ai)
#pragma unroll
                for (int m = 0; m < 4; ++m) {
                    const int row = row0 + ai * HALF + m * 16; const float rs = rsqrtf(sumsq1[row] * (1.0f / 2048.0f) + RMS_EPS) * sc0;
                    bf16_t* rowp = basep + (size_t)row * 2048 + col0;
#pragma unroll
                    for (int bj = 0; bj < 2; ++bj) { const f32x4 v0 = acc[ai][bj][m][0] * rs, v1 = acc[ai][bj][m][1] * rs;
                        u32x4 w; w.x = cvt_pk_bf16(v0[0], v0[1]); w.y = cvt_pk_bf16(v0[2], v0[3]); w.z = cvt_pk_bf16(v1[0], v1[1]); w.w = cvt_pk_bf16(v1[2], v1[3]);
                        *(u32x4*)(rowp + bj * HALF) = w; }
                }
        } else {
            const int wid = wr * 4 + wc; PG8_LAS unsigned char* my = scr + wid * 1280;
            const int lane = fq * 16 + fr, et = lane >> 5, hh = (lane >> 4) & 1, c = lane & 15, cc = 8 * (c >> 2) + 4 * et + (c & 3);
            const int b = u.pm >> 5, h = (u.pn & 7) >> 1;
#pragma unroll
            for (int ai = 0; ai < 2; ++ai) {
                const int chunk = (4 * u.pm + 2 * ai + wr) & 127; const size_t it = (size_t)(4 * b + h) * 128 + chunk;
#pragma unroll
                for (int m = 0; m < 4; ++m) {
                    const int row = row0 + ai * HALF + m * 16; const float rs = rsqrtf(sumsq1[row] * (1.0f / 2048.0f) + RMS_EPS);
#pragma unroll
                    for (int bj = 0; bj < 2; ++bj) { const f32x4 v0 = acc[ai][bj][m][0] * rs, v1 = acc[ai][bj][m][1] * rs;
                        u32x4 w; w.x = cvt_pk_bf16(v0[0], v0[1]); w.y = cvt_pk_bf16(v0[2], v0[3]); w.z = cvt_pk_bf16(v1[0], v1[1]); w.w = cvt_pk_bf16(v1[2], v1[3]);
                        *(PG8_LAS u32x4*)(my + fr * 80 + fq * 16) = w;
                        asm volatile("s_waitcnt lgkmcnt(0)" ::: "memory");
                        unsigned short hv[8];
#pragma unroll
                        for (int jj = 0; jj < 8; ++jj) hv[jj] = *(const PG8_LAS unsigned short*)(my + (8 * hh + jj) * 80 + cc * 2);
                        u32x4 o; o.x = (unsigned)hv[0] | ((unsigned)hv[1] << 16); o.y = (unsigned)hv[2] | ((unsigned)hv[3] << 16); o.z = (unsigned)hv[4] | ((unsigned)hv[5] << 16); o.w = (unsigned)hv[6] | ((unsigned)hv[7] << 16);
                        const int ne2 = 8 * (u.pn & 1) + 4 * bj + wc, ne = 2 * ne2 + et, sblk = m >> 1, q = 2 * (m & 1) + hh;
                        __builtin_nontemporal_store(o, (u32x4*)(VFp + ((it * 64 + ne * 2 + sblk) * 64 + 16 * q + c) * 8));
                        asm volatile("s_waitcnt lgkmcnt(0)" ::: "memory");
                    }
                }
            }
        }
    }
};
template <class Epi, class Sched, bool ALIGN_EPI = false, bool SP2 = false>
__device__ __forceinline__ void gemm_phase(PG8_LAS unsigned char* lds, const Gemm g, const Sched& S, const Epi& E) {
    const int tid = threadIdx.x, wid = __builtin_amdgcn_readfirstlane(tid >> 6), lane = tid & 63, wr = wid >> 2, wc = wid & 3, fr = lane & 15, fq = lane >> 4;
    const int K = g.K, nt = K / BK;
    unsigned voffA[2], voffB[2];
#pragma unroll
    for (int i = 0; i < 2; ++i) { int R, C; stage_rc(tid * 16 + i * 8192, R, C); const int Rb = Epi::PERM ? ((R & ~31) + perm32(R & 31)) : R;
        voffA[i] = (unsigned)(R * K + C) * 2u; voffB[i] = (unsigned)(Rb * K + C) * 2u; }
    const size_t kstep = (size_t)(BK * 2);
    const size_t hstep = (size_t)HALF * K * 2;
    const size_t tstep = 2 * hstep;
    const unsigned ldsw = (unsigned)wid * 1024u;
    const int aoff = lds_byte(wr * 64 + fr, fq * 8), boff = lds_byte(wc * 32 + fr, fq * 8);
#define PG8_SA(b, h) (((b) * 2 + (h)) * HTB)
#define PG8_SB(b, h) ((4 + (b) * 2 + (h)) * HTB)
#define PG8_STAGE(bufoff, gbase, voff) do { _Pragma("unroll") for (int _i = 0; _i < 2; ++_i) \
        __builtin_amdgcn_global_load_lds((const unsigned*)((const char*)(gbase) + (voff)[_i]), (PG8_LAS unsigned*)(lds + (bufoff) + ldsw + _i * 8192), 16, 0, 0); } while (0)
#define PG8_LDA(dst, b, h) do { _Pragma("unroll") for (int m = 0; m < 4; ++m) _Pragma("unroll") for (int k = 0; k < 2; ++k) dst[m][k] = *(const PG8_LAS bf16x8*)(lds + PG8_SA(b, h) + aoff + m * 2048 + k * 1024); } while (0)
#define PG8_LDB(dst, b, h) do { _Pragma("unroll") for (int n = 0; n < 2; ++n) _Pragma("unroll") for (int k = 0; k < 2; ++k) dst[n][k] = *(const PG8_LAS bf16x8*)(lds + PG8_SB(b, h) + boff + n * 2048 + k * 1024); } while (0)
#define PG8_MMA(ai, bj, At, Bt) do { __builtin_amdgcn_s_setprio(1); _Pragma("unroll") for (int m = 0; m < 4; ++m) _Pragma("unroll") for (int n = 0; n < 2; ++n) _Pragma("unroll") for (int k = 0; k < 2; ++k) \
        acc[ai][bj][m][n] = __builtin_amdgcn_mfma_f32_16x16x32_bf16(Bt[n][k], At[m][k], acc[ai][bj][m][n], 0, 0, 0); __builtin_amdgcn_s_setprio(0); } while (0)
#define PG8_WAIT_V(n) asm volatile("s_waitcnt vmcnt(" #n ")" ::: "memory")
#define PG8_WAIT_L(n) asm volatile("s_waitcnt lgkmcnt(" #n ")" ::: "memory")
#define PG8_BAR __builtin_amdgcn_s_barrier()
#define PG8_SCHED __builtin_amdgcn_sched_barrier(0)
    Unit cur, nxt; int ui = 0;
    if (!S.next(0, cur)) return;
    f32x4 acc[2][2][4][2];
#pragma unroll
    for (int a = 0; a < 2; ++a)
#pragma unroll
        for (int b = 0; b < 2; ++b)
#pragma unroll
            for (int m = 0; m < 4; ++m)
#pragma unroll
                for (int n = 0; n < 2; ++n) acc[a][b][m][n] = (f32x4){0.f, 0.f, 0.f, 0.f};
    bf16x8 At[4][2], B0[2][2], B1[2][2];
    const char* cA = (const char*)g.A + (size_t)cur.pm * tstep; const char* cB = (const char*)g.Bt + (size_t)cur.pn * tstep;
    S.a_ready(cur);
    if constexpr (SP2) {
        PG8_STAGE(PG8_SB(0, 0), cB, voffB); PG8_STAGE(PG8_SB(0, 1), cB + hstep, voffB); PG8_STAGE(PG8_SA(0, 0), cA, voffA); PG8_STAGE(PG8_SA(0, 1), cA + hstep, voffA);
        if (wr == 1) PG8_BAR;
        PG8_WAIT_V(2); PG8_BAR;
        PG8_STAGE(PG8_SB(1, 0), cB + kstep, voffB); PG8_STAGE(PG8_SA(1, 0), cA + kstep, voffA); PG8_STAGE(PG8_SB(1, 1), cB + hstep + kstep, voffB);
        PG8_WAIT_V(6); PG8_BAR;
    } else {
        PG8_STAGE(PG8_SB(0, 0), cB, voffB); PG8_STAGE(PG8_SA(0, 0), cA, voffA); PG8_STAGE(PG8_SB(0, 1), cB + hstep, voffB); PG8_STAGE(PG8_SA(0, 1), cA + hstep, voffA);
        if (wr == 1) PG8_BAR;
        PG8_WAIT_V(4); PG8_BAR;
        PG8_STAGE(PG8_SB(1, 0), cB + kstep, voffB); PG8_STAGE(PG8_SA(1, 0), cA + kstep, voffA); PG8_STAGE(PG8_SB(1, 1), cB + hstep + kstep, voffB);
        PG8_WAIT_V(6); PG8_BAR;
    }
    for (;;) {
        const bool has_next = S.next(ui + 1, nxt);
        const char* nA = has_next ? (const char*)g.A + (size_t)nxt.pm * tstep : cA; const char* nB = has_next ? (const char*)g.Bt + (size_t)nxt.pn * tstep : cB;
        for (int t = 0; t < nt; t += 2) {
            const bool last = (t == nt - 2);
            const char* a1 = cA + (size_t)(t + 1) * kstep;
            const char* a2 = last ? nA : cA + (size_t)(t + 2) * kstep; const char* b2 = last ? nB : cB + (size_t)(t + 2) * kstep;
            const char* a3 = a2 + kstep; const char* b3 = b2 + kstep;
            if (last && has_next) S.a_ready(nxt);
            if constexpr (SP2) {
            PG8_LDB(B0, 0, 0); PG8_LDB(B1, 0, 1); PG8_SCHED; PG8_LDA(At, 0, 0); PG8_STAGE(PG8_SA(1, 1), a1 + hstep, voffA);
            PG8_WAIT_V(8); PG8_WAIT_L(0); PG8_BAR; PG8_MMA(0, 0, At, B0); PG8_MMA(0, 1, At, B1); PG8_BAR; PG8_SCHED;
            PG8_LDA(At, 0, 1); PG8_STAGE(PG8_SB(0, 0), b2, voffB); PG8_STAGE(PG8_SB(0, 1), b2 + hstep, voffB); PG8_STAGE(PG8_SA(0, 0), a2, voffA);
            PG8_WAIT_V(8); PG8_WAIT_L(0); PG8_BAR; PG8_MMA(1, 0, At, B0); PG8_MMA(1, 1, At, B1); PG8_BAR; PG8_SCHED;
            PG8_LDB(B0, 1, 0); PG8_LDB(B1, 1, 1); PG8_SCHED; PG8_LDA(At, 1, 0); PG8_STAGE(PG8_SA(0, 1), a2 + hstep, voffA);
            PG8_WAIT_V(8); PG8_WAIT_L(0); PG8_BAR; PG8_MMA(0, 0, At, B0); PG8_MMA(0, 1, At, B1); PG8_BAR; PG8_SCHED;
            PG8_LDA(At, 1, 1); PG8_STAGE(PG8_SB(1, 0), b3, voffB); PG8_STAGE(PG8_SB(1, 1), b3 + hstep, voffB); PG8_STAGE(PG8_SA(1, 0), a3, voffA);
            PG8_WAIT_V(8); PG8_WAIT_L(0); PG8_BAR; PG8_MMA(1, 0, At, B0); PG8_MMA(1, 1, At, B1); PG8_BAR; PG8_SCHED;
            } else {
            PG8_LDB(B0, 0, 0); PG8_SCHED; PG8_LDA(At, 0, 0); PG8_STAGE(PG8_SA(1, 1), a1 + hstep, voffA);
            PG8_WAIT_L(8); PG8_BAR; PG8_WAIT_L(0); PG8_MMA(0, 0, At, B0); PG8_BAR; PG8_SCHED;
            PG8_LDB(B1, 0, 1); PG8_STAGE(PG8_SB(0, 0), b2, voffB);
            PG8_BAR; PG8_WAIT_L(0); PG8_MMA(0, 1, At, B1); PG8_BAR;
            PG8_LDA(At, 0, 1); PG8_STAGE(PG8_SA(0, 0), a2, voffA);
            PG8_BAR; PG8_WAIT_L(0); PG8_MMA(1, 0, At, B0); PG8_BAR; PG8_SCHED;
            PG8_STAGE(PG8_SB(0, 1), b2 + hstep, voffB);
            PG8_WAIT_V(6); PG8_BAR; PG8_MMA(1, 1, At, B1); PG8_BAR;
            PG8_LDB(B0, 1, 0); PG8_SCHED; PG8_LDA(At, 1, 0); PG8_STAGE(PG8_SA(0, 1), a2 + hstep, voffA);
            PG8_WAIT_L(8); PG8_BAR; PG8_WAIT_L(0); PG8_MMA(0, 0, At, B0); PG8_BAR; PG8_SCHED;
            PG8_LDB(B1, 1, 1); PG8_STAGE(PG8_SB(1, 0), b3, voffB);
            PG8_BAR; PG8_WAIT_L(0); PG8_MMA(0, 1, At, B1); PG8_BAR;
            PG8_LDA(At, 1, 1); PG8_STAGE(PG8_SA(1, 0), a3, voffA);
            PG8_BAR; PG8_WAIT_L(0); PG8_MMA(1, 0, At, B0); PG8_BAR; PG8_SCHED;
            PG8_STAGE(PG8_SB(1, 1), b3 + hstep, voffB);
            PG8_WAIT_V(6); PG8_BAR; PG8_MMA(1, 1, At, B1); PG8_BAR;
            }
        }
        if constexpr (ALIGN_EPI) { if (wr == 0) PG8_BAR; }
        if constexpr (!Epi::AFTER_DRAIN) { E(acc, cur, wr, wc, fr, fq); S.done(cur); }
        if (!has_next) break;
#pragma unroll
        for (int a = 0; a < 2; ++a)
#pragma unroll
            for (int b = 0; b < 2; ++b)
#pragma unroll
                for (int m = 0; m < 4; ++m)
#pragma unroll
                    for (int n = 0; n < 2; ++n) acc[a][b][m][n] = (f32x4){0.f, 0.f, 0.f, 0.f};
        cur = nxt; cA = nA; cB = nB; ++ui;
        if constexpr (ALIGN_EPI) { if (wr == 1) PG8_BAR; }
    }
    PG8_WAIT_V(0);
    if constexpr (!ALIGN_EPI) { if (wr == 0) PG8_BAR; }
    PG8_BAR;
    if constexpr (Epi::AFTER_DRAIN) { E.fused(acc, cur, wr, wc, fr, fq, lds, wid, lane); S.done(cur); }
#undef PG8_SA
#undef PG8_SB
#undef PG8_STAGE
#undef PG8_LDA
#undef PG8_LDB
#undef PG8_MMA
#undef PG8_WAIT_V
#undef PG8_WAIT_L
#undef PG8_BAR
#undef PG8_SCHED
}
}
constexpr int M = 16384, DM = 2048, TSEQ = 8192, N0 = 8192, N1 = 6144, N1RAW = 6160, NHEAD = 4, DK = 256, DV = 512, CH = 64, NCH = 128;
constexpr float EPS = 1e-6f;
constexpr int NWAVES = 8;
constexpr size_t MiB = 1u << 20;
constexpr size_t WS_CTL = 0, CTL_ZERO_BYTES = 2 * MiB;
constexpr size_t WS_SUMSQ1 = 1 * MiB, WS_SUMSQ2 = 1 * MiB + 65536, WS_HSUM = 1 * MiB + 131072;
constexpr size_t WS_GKLR = 2 * MiB;
constexpr size_t WS_EB = 3 * MiB;
constexpr size_t WS_WGT = 4 * MiB;
constexpr size_t WS_RSTD0 = 4 * MiB + 524288;
constexpr size_t WS_HA = 5 * MiB, WS_HB = 7 * MiB;
constexpr size_t WS_W0T = 8 * MiB, WS_WO0T = 40 * MiB, WS_W1T = 48 * MiB, WS_WO1T = 72 * MiB;
constexpr size_t WS_VF = 336 * MiB;
constexpr size_t WS_BUFA = 80 * MiB;
constexpr size_t WS_BUFB = 144 * MiB;
constexpr size_t WS_BUFC = 208 * MiB;
constexpr size_t WS_X1 = 272 * MiB;
constexpr size_t WS_BUFD = 400 * MiB;
constexpr size_t WS_PF = 464 * MiB;
constexpr size_t WS_DUMMY = 472 * MiB;
constexpr size_t WS_END = 473 * MiB;
constexpr int LDS_BYTES = 147456;

#define GAS __attribute__((address_space(1)))
#define LAS __attribute__((address_space(3)))
typedef unsigned short bf16;
typedef unsigned v4u __attribute__((ext_vector_type(4)));
typedef unsigned v2u __attribute__((ext_vector_type(2)));
typedef float f32x4 __attribute__((ext_vector_type(4)));
typedef float f32x2 __attribute__((ext_vector_type(2)));
typedef short bf16x8 __attribute__((ext_vector_type(8)));
#define LDS_WAIT() asm volatile("s_waitcnt lgkmcnt(0)" ::: "memory")
#define WG_BAR() do { asm volatile("s_waitcnt lgkmcnt(0)" ::: "memory"); __builtin_amdgcn_s_barrier(); asm volatile("" ::: "memory"); } while (0)
#define MFMA16(a, b, c) __builtin_amdgcn_mfma_f32_16x16x32_bf16((a), (b), (c), 0, 0, 0)
__device__ __forceinline__ unsigned pk2(float lo, float hi) { return pg8::cvt_pk_bf16(lo, hi); }
__device__ __forceinline__ unsigned f2bf_sw(float f) { const unsigned u = __float_as_uint(f); return (u + 0x7fffu + ((u >> 16) & 1u)) >> 16; }
__device__ __forceinline__ unsigned pk2_sw(float lo, float hi) { return f2bf_sw(lo) | (f2bf_sw(hi) << 16); }
__device__ __forceinline__ float bflo(unsigned u) { return __uint_as_float(u << 16); }
__device__ __forceinline__ float bfhi(unsigned u) { return __uint_as_float(u & 0xffff0000u); }
__device__ __forceinline__ float wave_sum(float v) {
#pragma unroll
    for (int o = 1; o < 64; o <<= 1) v += __shfl_xor(v, o);
    return v;
}
#define XB_TMO      128
#define XB_XCNT(j)  (256  + 64 * (j))
#define XB_XSUB(j)  (1280 + 64 * (j))
#define XB_XGEN(j)  (2304 + 64 * (j))
#define XB_TOP      3328
#define XB_TOPGEN   3392
#define XCD_BAR_WORDS 3456
#define XB_SPIN_CAP (1u << 18)

__device__ __forceinline__ unsigned xb_ld(unsigned* p)              { return __hip_atomic_load(p, __ATOMIC_RELAXED, __HIP_MEMORY_SCOPE_AGENT); }
__device__ __forceinline__ unsigned xb_add(unsigned* p, unsigned v) { return __hip_atomic_fetch_add(p, v, __ATOMIC_RELAXED, __HIP_MEMORY_SCOPE_AGENT); }
__device__ __forceinline__ unsigned xb_xcc_id() { return (unsigned)__builtin_amdgcn_s_getreg((3 << 11) | 20) & 0xFu; }
#define XB_SPIN(cond, bar) do { unsigned _sp = 0; while (cond) { __builtin_amdgcn_s_sleep(1); \
    if ((++_sp & 255u) == 0u) { if (xb_ld(&(bar)[XB_TMO])) break; if (_sp > XB_SPIN_CAP) { atomicAdd(&(bar)[XB_TMO], 1u); break; } } } } while (0)

struct XcdBarrier {
    unsigned* bar; unsigned x;
    volatile LAS unsigned* st;
};

__device__ __forceinline__ XcdBarrier xcd_barrier_post(unsigned* bar, volatile LAS unsigned* st) {
    XcdBarrier b; b.bar = bar; b.x = xb_xcc_id(); b.st = st;
    if (threadIdx.x == 0) (void)xb_add(&bar[XB_XCNT(b.x)], 1u);
    return b;
}
__device__ __forceinline__ void xcd_barrier_complete(unsigned* bar, unsigned x, unsigned& nloc, unsigned& nx) {
    const unsigned G = gridDim.x * gridDim.y * gridDim.z;
    unsigned sum, cnt, mine, sp = 0u;
    for (;;) {
        sum = 0u; cnt = 0u; mine = 0u;
#pragma unroll
        for (unsigned j = 0; j < 16; ++j) { const unsigned c = xb_ld(&bar[XB_XCNT(j)]); sum += c; cnt += (c > 0u) ? 1u : 0u; mine = (j == x) ? c : mine; }
        if (sum == G) break;
        __builtin_amdgcn_s_sleep(1);
        if ((++sp & 255u) == 0u) { if (xb_ld(&bar[XB_TMO])) break; if (sp > XB_SPIN_CAP) { atomicAdd(&bar[XB_TMO], 1u); break; } }
    }
    nloc = mine > 0u ? mine : 1u; nx = cnt > 0u ? cnt : 1u;
}

__device__ __forceinline__ void xcd_barrier(const XcdBarrier& b) {
    asm volatile("s_waitcnt vmcnt(0)" ::: "memory");
    __syncthreads();
    if (threadIdx.x == 0) {
        unsigned* bar = b.bar;
        __builtin_amdgcn_s_waitcnt(0);
        unsigned nloc = b.st[0], nx = b.st[1];
        if (nloc == 0u) { xcd_barrier_complete(bar, b.x, nloc, nx); b.st[0] = nloc; b.st[1] = nx; }
        const unsigned old = xb_add(&bar[XB_XSUB(b.x)], 1u);
        const unsigned gen = old / nloc;
        if (old + 1u == (gen + 1u) * nloc) {
            __builtin_amdgcn_fence(__ATOMIC_RELEASE, "agent");
            asm volatile("s_waitcnt vmcnt(0)" ::: "memory");
            const unsigned og = xb_add(&bar[XB_TOP], 1u);
            const unsigned tg = og / nx;
            if (og + 1u == (tg + 1u) * nx) xb_add(&bar[XB_TOPGEN], 1u);
            else XB_SPIN(xb_ld(&bar[XB_TOPGEN]) == tg, bar);
            __builtin_amdgcn_fence(__ATOMIC_ACQUIRE, "agent");
            xb_add(&bar[XB_XGEN(b.x)], 1u);
            asm volatile("s_waitcnt vmcnt(0)" ::: "memory");
        } else {
            XB_SPIN(xb_ld(&bar[XB_XGEN(b.x)]) == gen, bar);
            __builtin_amdgcn_fence(__ATOMIC_ACQUIRE, "agent");
            asm volatile("s_waitcnt vmcnt(0)" ::: "memory");
        }
    }
    __syncthreads();
}
__device__ __forceinline__ int virt0(int col) { const int g = col >> 11, e = col & 2047, pn = e >> 6, el = e & 63; return 256 * pn + 128 * (g >> 1) + 32 * (el >> 4) + 16 * (g & 1) + (el & 15); }
__device__ __forceinline__ void p0_transpose_item(const float* W, int ldw, int nblk, int K, bf16* WT, int mode, const float* rowscale, LAS float* scr, int item, int lane) {
    const int kb = item / nblk, nb = item % nblk, k0 = 64 * kb, n0 = 32 * nb;
    f32x4 wv[8]; const int kr = lane >> 3, c4 = lane & 7;
#pragma unroll
    for (int i = 0; i < 8; ++i) wv[i] = __builtin_nontemporal_load((const GAS f32x4*)(W + (size_t)(k0 + 8 * i + kr) * ldw + n0 + 4 * c4));
    if (rowscale) {
#pragma unroll
        for (int i = 0; i < 8; ++i) wv[i] = wv[i] * rowscale[k0 + 8 * i + kr];
    }
#pragma unroll
    for (int i = 0; i < 8; ++i) { LAS float* d = scr + (8 * i + kr) * 33 + 4 * c4; d[0] = wv[i].x; d[1] = wv[i].y; d[2] = wv[i].z; d[3] = wv[i].w; }
    LDS_WAIT(); asm volatile("" ::: "memory");
    const int c = lane & 7;
#pragma unroll
    for (int j = 0; j < 4; ++j) { const int n = (lane >> 3) + 8 * j; const LAS float* s = scr + (8 * c) * 33 + n;
        v4u o; o.x = pk2(s[0 * 33], s[1 * 33]); o.y = pk2(s[2 * 33], s[3 * 33]); o.z = pk2(s[4 * 33], s[5 * 33]); o.w = pk2(s[6 * 33], s[7 * 33]);
        const int nn = n0 + n; const int dst = mode == 1 ? virt0(nn) : (mode == 2 ? (nn + 4096) % 6144 : nn);
        *(GAS v4u*)(WT + (size_t)dst * K + k0 + 8 * c) = o; }
    LDS_WAIT(); asm volatile("" ::: "memory");
}
__device__ __forceinline__ void rms_rows2_to_bf16(const float* xrow0, const float* xrow1, const float* w, bf16* orow0, bf16* orow1, float* rs0, float* rs1, int lane) {
    const GAS f32x4* xr0 = (const GAS f32x4*)xrow0 + lane; const GAS f32x4* xr1 = (const GAS f32x4*)xrow1 + lane; const GAS f32x4* wr = (const GAS f32x4*)w + lane;
    f32x4 v0[8], v1[8]; float s0 = 0.f, s1 = 0.f;
#pragma unroll
    for (int j = 0; j < 8; ++j) { v0[j] = __builtin_nontemporal_load(xr0 + 64 * j); v1[j] = __builtin_nontemporal_load(xr1 + 64 * j); }
#pragma unroll
    for (int j = 0; j < 8; ++j) { s0 += (v0[j].x * v0[j].x + v0[j].y * v0[j].y) + (v0[j].z * v0[j].z + v0[j].w * v0[j].w); s1 += (v1[j].x * v1[j].x + v1[j].y * v1[j].y) + (v1[j].z * v1[j].z + v1[j].w * v1[j].w); }
    const float r0 = rsqrtf(wave_sum(s0) * (1.f / DM) + EPS), r1 = rsqrtf(wave_sum(s1) * (1.f / DM) + EPS);
    if (lane == 0) { *rs0 = r0; *rs1 = r1; }
    GAS v2u* o0 = (GAS v2u*)orow0 + lane; GAS v2u* o1 = (GAS v2u*)orow1 + lane;
#pragma unroll
    for (int j = 0; j < 8; ++j) { const f32x4 ww = wr[64 * j]; v2u a, b;
        a.x = pk2(v0[j].x * r0 * ww.x, v0[j].y * r0 * ww.y); a.y = pk2(v0[j].z * r0 * ww.z, v0[j].w * r0 * ww.w); o0[64 * j] = a;
        b.x = pk2(v1[j].x * r1 * ww.x, v1[j].y * r1 * ww.y); b.y = pk2(v1[j].z * r1 * ww.z, v1[j].w * r1 * ww.w); o1[64 * j] = b; }
}

__device__ __forceinline__ void unpack8(const v4u x, float (&f)[8]) { f[0] = bflo(x.x); f[1] = bfhi(x.x); f[2] = bflo(x.y); f[3] = bfhi(x.y); f[4] = bflo(x.z); f[5] = bfhi(x.z); f[6] = bflo(x.w); f[7] = bfhi(x.w); }
__device__ __forceinline__ void conv_fix_panel(const float* HA, const float* HB, const float* wconv, bf16* Y, int pm, int tid) {
    if ((pm & 31) == 0) return;
    const int e0 = tid * 4;
    const f32x4 bz0 = *(const GAS f32x4*)(HA + ((size_t)pm * 4 + 0) * 2048 + e0), bz1 = *(const GAS f32x4*)(HA + ((size_t)pm * 4 + 1) * 2048 + e0);
    const f32x4 cu0 = *(const GAS f32x4*)(HA + ((size_t)pm * 4 + 2) * 2048 + e0), cu1 = *(const GAS f32x4*)(HA + ((size_t)pm * 4 + 3) * 2048 + e0);
    const f32x4 cm2 = *(const GAS f32x4*)(HB + ((size_t)(pm - 1) * 2 + 0) * 2048 + e0), cm1 = *(const GAS f32x4*)(HB + ((size_t)(pm - 1) * 2 + 1) * 2048 + e0);
    f32x4 w0, w1, w2;
#pragma unroll
    for (int j = 0; j < 4; ++j) { w0[j] = wconv[(e0 + j) * 3 + 0]; w1[j] = wconv[(e0 + j) * 3 + 1]; w2[j] = wconv[(e0 + j) * 3 + 2]; }
    const f32x4 y0 = bz0 * (w0 * cm2 + w1 * cm1 + w2 * cu0), y1 = bz1 * (w0 * cm1 + w1 * cu0 + w2 * cu1);
    *(GAS v2u*)(Y + (size_t)(pm * 256) * 2048 + e0) = (v2u){pk2(y0[0], y0[1]), pk2(y0[2], y0[3])};
    *(GAS v2u*)(Y + (size_t)(pm * 256 + 1) * 2048 + e0) = (v2u){pk2(y1[0], y1[1]), pk2(y1[2], y1[3])};
}

__device__ __forceinline__ void gklr_phase(LAS unsigned char* lds, const bf16* X1B, const bf16* WGT, const float* sumsq1, float* GKLR, int G, int rg0, int wave, int lane) {
    const int r = lane & 15, q = lane >> 4, kh = wave & 1;
    for (int rg = rg0 + (wave >> 1); rg - (wave >> 1) < M / 16; rg += G * 4) {
        const int row0 = rg * 16; const bool live = rg < M / 16;
        f32x4 acc = {0.f, 0.f, 0.f, 0.f};
        if (live) {
            const GAS bf16x8* ap = (const GAS bf16x8*)(X1B + (size_t)(row0 + r) * 2048 + 1024 * kh + 8 * q);
            const GAS bf16x8* bp = (const GAS bf16x8*)(WGT + (size_t)r * 2048 + 1024 * kh + 8 * q);
#pragma unroll 8
            for (int s = 0; s < 32; ++s) acc = MFMA16(__builtin_nontemporal_load(ap + 4 * s), bp[4 * s], acc);
        }
        if (kh) *(LAS f32x4*)(lds + ((wave >> 1) * 64 + lane) * 16) = acc;
        WG_BAR();
        if (!kh && live) { acc = acc + *(const LAS f32x4*)(lds + ((wave >> 1) * 64 + lane) * 16);
#pragma unroll
            for (int j = 0; j < 4; ++j) { const int row = row0 + 4 * q + j; GKLR[(size_t)row * 16 + r] = acc[j] * rsqrtf(sumsq1[row] * (1.f / DM) + EPS); } }
        WG_BAR();
    }
}

constexpr int P5_QS = 0, P5_KS = 33792, P5_KST = 67584, P5_PS = 104448, P5_GLR = 113664, P5_TOT = 117760;
__device__ __forceinline__ float logsig(float x) { return fminf(x, 0.f) - __logf(1.f + __expf(-fabsf(x))); }
__device__ __forceinline__ void gate_phase(LAS unsigned char* lds, const bf16* QK, const bf16* V, const float* GKLR, const float* wgk2, const float* bgk2,
                                           bf16* QF, bf16* KF, bf16* PF, bf16* VF, float* EB, int G, int vid, int qpm, int tid, int wave, int lane) {
    const int r = lane & 15, q = lane >> 4;
#define P5_ITEM(ITEM0) (qpm >= 0 ? ((4 * (qpm & 31) + 3 - ((ITEM0) >> 8)) << 3) | (4 * (qpm >> 5) + (vid >> 6)) : ((1023 - (ITEM0)) ^ 7))
    unsigned qx[16], kx[16]; float wA[16], wB[16]; f32x2 bias = {0.f, 0.f}; int hprev = -1;
    const int dp = tid & 127, tq = tid >> 7, d0 = 2 * dp;
#define P5_FETCH(ITEM0) do { const int item_ = P5_ITEM(ITEM0); const int bh_ = item_ & 7, c_ = item_ >> 3; const int rb_ = (bh_ >> 2) * TSEQ + c_ * CH, kc_ = (bh_ & 3) * DK + d0; \
        _Pragma("unroll") for (int i = 0; i < 16; ++i) { const size_t ro = (size_t)(rb_ + 16 * tq + i) * 2048 + kc_; \
            qx[i] = __builtin_nontemporal_load((const GAS unsigned*)(QK + ro)); kx[i] = __builtin_nontemporal_load((const GAS unsigned*)(QK + ro + 1024)); } } while (0)
    if (vid < 1024) P5_FETCH(vid);
    for (int item0 = vid; item0 < 1024; item0 += G) {
        const int item = P5_ITEM(item0);
        const int bh = item & 7, c = item >> 3, b = bh >> 2, h = bh & 3; const size_t it = (size_t)bh * NCH + c; const int rowbase = b * TSEQ + c * CH;
        if (tid < 256) { const int t = tid >> 2, r4 = tid & 3; *(LAS f32x4*)(lds + P5_GLR + t * 64 + r4 * 16) = *(const GAS f32x4*)(GKLR + (size_t)(rowbase + t) * 16 + 4 * r4); }
        const int kc = h * DK + d0;
        if (h != hprev) {
#pragma unroll
            for (int rr = 0; rr < 16; ++rr) { const f32x2 w = *(const GAS f32x2*)(wgk2 + rr * 1024 + kc); wA[rr] = w.x; wB[rr] = w.y; }
            bias = *(const GAS f32x2*)(bgk2 + kc); hprev = h; }
        WG_BAR();
        float blA[16], blB[16]; float cumA = 0.f, cumB = 0.f;
#pragma unroll
        for (int i = 0; i < 16; ++i) { const LAS f32x4* gp = (const LAS f32x4*)(lds + P5_GLR + (16 * tq + i) * 64);
            float la = bias.x, lb = bias.y;
#pragma unroll
            for (int r4 = 0; r4 < 4; ++r4) { const f32x4 g = gp[r4];
                la += g.x * wA[4 * r4] + g.y * wA[4 * r4 + 1] + g.z * wA[4 * r4 + 2] + g.w * wA[4 * r4 + 3];
                lb += g.x * wB[4 * r4] + g.y * wB[4 * r4 + 1] + g.z * wB[4 * r4 + 2] + g.w * wB[4 * r4 + 3]; }
            cumA += logsig(la) * 0.0625f; cumB += logsig(lb) * 0.0625f; blA[i] = cumA; blB[i] = cumB; }
        *(LAS f32x2*)(lds + P5_TOT + (tq * 256 + d0) * 4) = (f32x2){cumA, cumB};
        WG_BAR();
        float offA = 0.f, offB = 0.f, lastA = 0.f, lastB = 0.f;
#pragma unroll
        for (int k = 0; k < 4; ++k) { const f32x2 tt = *(const LAS f32x2*)(lds + P5_TOT + (k * 256 + d0) * 4); if (k < tq) { offA += tt.x; offB += tt.y; } lastA += tt.x; lastB += tt.y; }
        if (tq == 0) *(GAS f32x2*)(EB + it * 256 + d0) = (f32x2){__expf(lastA), __expf(lastB)};
        unsigned kw[16];
#pragma unroll
        for (int i = 0; i < 16; ++i) { const int t = 16 * tq + i; const float bA = offA + blA[i], bB = offB + blB[i];
            const float eA = __expf(bA), eB = __expf(bB), nA = __expf(-bA), nB = __expf(-bB);
            *(LAS unsigned*)(lds + P5_QS + t * 528 + d0 * 2) = pk2(bflo(qx[i]) * eA, bfhi(qx[i]) * eB);
            kw[i] = pk2(bflo(kx[i]) * nA, bfhi(kx[i]) * nB);
            *(LAS unsigned*)(lds + P5_KS + t * 528 + d0 * 2) = kw[i]; }
        if (item0 + G < 1024) P5_FETCH(item0 + G);
#pragma unroll
        for (int g = 0; g < 2; ++g) { v4u lo, hi;
#pragma unroll
            for (int k = 0; k < 4; ++k) { const unsigned a = kw[8 * g + 2 * k], bb = kw[8 * g + 2 * k + 1]; lo[k] = (a & 0xffffu) | (bb << 16); hi[k] = (a >> 16) | (bb & 0xffff0000u); }
            *(LAS v4u*)(lds + P5_KST + d0 * 144 + (16 * tq + 8 * g) * 2) = lo; *(LAS v4u*)(lds + P5_KST + (d0 + 1) * 144 + (16 * tq + 8 * g) * 2) = hi; }
        WG_BAR();
#pragma unroll
        for (int k = 0; k < 2; ++k) { const int tl = 2 * wave + k, mt = tl >> 2, nt = tl & 3; f32x4 acc = {0.f, 0.f, 0.f, 0.f};
            if (nt <= mt) {
#pragma unroll
                for (int s = 0; s < 8; ++s) { const bf16x8 qf = *(const LAS bf16x8*)(lds + P5_QS + (16 * mt + r) * 528 + (32 * s + 8 * q) * 2);
                    const bf16x8 kf = *(const LAS bf16x8*)(lds + P5_KS + (16 * nt + r) * 528 + (32 * s + 8 * q) * 2);
                    acc = MFMA16(kf, qf, acc); }
            }
            const int i_ = 16 * mt + r, j0 = 16 * nt + 4 * q; float p[4];
#pragma unroll
            for (int jj = 0; jj < 4; ++jj) p[jj] = (j0 + jj <= i_) ? acc[jj] : 0.f;
            *(LAS v2u*)(lds + P5_PS + i_ * 144 + j0 * 2) = (v2u){pk2(p[0], p[1]), pk2(p[2], p[3])}; }
#pragma unroll
        for (int i = 0; i < 4; ++i) { const int blk = wave * 4 + i, mt = blk >> 3, s = blk & 7;
            const v4u f = *(const LAS v4u*)(lds + P5_QS + (16 * mt + r) * 528 + (32 * s + 8 * q) * 2);
            *(GAS v4u*)(QF + (it * 32 + blk) * 512 + lane * 8) = f; }
#pragma unroll
        for (int i = 0; i < 4; ++i) { const int blk = wave * 4 + i, md = blk >> 1, s = blk & 1;
            const v4u f = *(const LAS v4u*)(lds + P5_KST + (16 * md + r) * 144 + (32 * s + 8 * q) * 2);
            *(GAS v4u*)(KF + (it * 32 + blk) * 512 + lane * 8) = f; }
        WG_BAR();
        { const int mt = wave >> 1, s = wave & 1;
          const v4u f = *(const LAS v4u*)(lds + P5_PS + (16 * mt + r) * 144 + (32 * s + 8 * q) * 2);
          *(GAS v4u*)(PF + (it * 8 + wave) * 512 + lane * 8) = f; }
        WG_BAR();
    }
}

struct ULd { bf16x8 vfn; bf16x8 kf[2][2]; f32x4 eb[2]; };
struct OLd { bf16x8 qf[4]; bf16x8 pf; };
__device__ __forceinline__ void u_load(ULd& L, const bf16* KF, const bf16* VF, const float* EB, size_t it, int ne2, int dh, int w, int lane) {
    L.vfn = __builtin_nontemporal_load((const GAS bf16x8*)(VF + (it * 64 + ne2 * 4 + w) * 512) + lane);
    const GAS bf16x8* kp = (const GAS bf16x8*)(KF + (it * 32 + 16 * dh + 4 * w) * 512) + lane;
#pragma unroll
    for (int i = 0; i < 2; ++i)
#pragma unroll
        for (int s = 0; s < 2; ++s) L.kf[i][s] = kp[(2 * i + s) * 64];
    const GAS f32x4* ep = (const GAS f32x4*)(EB + it * 256 + 128 * dh + 32 * w + 4 * (lane >> 4));
#pragma unroll
    for (int i = 0; i < 2; ++i) L.eb[i] = ep[4 * i];
}
__device__ __forceinline__ void o_load(OLd& L, const bf16* QF, const bf16* PF, size_t it, int dh, int mt, int lane) {
    const GAS bf16x8* qp = (const GAS bf16x8*)(QF + (it * 32 + 8 * mt + 4 * dh) * 512) + lane;
#pragma unroll
    for (int s = 0; s < 4; ++s) L.qf[s] = qp[s * 64];
    L.pf = *((const GAS bf16x8*)(PF + (it * 8 + 2 * mt + dh) * 512) + lane);
}
constexpr int SB_STRIDE = 272, SB_BYTES = 32 * SB_STRIDE;
constexpr int VFB_OFF = 2 * SB_BYTES, VFB_BYTES = 4096;
__device__ __forceinline__ void u_step(const ULd& L, const ULd& Ln, f32x4 (&S)[2][2], LAS unsigned char* sb_nxt, const LAS unsigned char* vfb_cur, LAS unsigned char* vfb_nxt, int w, int lane) {
    const int c = lane & 15, q = lane >> 4;
    bf16x8 vf[2][2];
#pragma unroll
    for (int et = 0; et < 2; ++et)
#pragma unroll
        for (int s = 0; s < 2; ++s) vf[et][s] = *(const LAS bf16x8*)(vfb_cur + ((2 * et + s) * 64 + lane) * 16);
    *(LAS bf16x8*)(vfb_nxt + (w * 64 + lane) * 16) = Ln.vfn;
#pragma unroll
    for (int i = 0; i < 2; ++i)
#pragma unroll
        for (int et = 0; et < 2; ++et) {
            S[et][i] = MFMA16(L.kf[i][0], vf[et][0], S[et][i]); S[et][i] = MFMA16(L.kf[i][1], vf[et][1], S[et][i]);
        }
#pragma unroll
    for (int i = 0; i < 2; ++i)
#pragma unroll
        for (int et = 0; et < 2; ++et) {
            S[et][i] = S[et][i] * L.eb[i];
            *(LAS v2u*)(sb_nxt + (16 * et + c) * SB_STRIDE + (32 * w + 16 * i + 4 * q) * 2) = (v2u){pk2(S[et][i][0], S[et][i][1]), pk2(S[et][i][2], S[et][i][3])};
        }
    WG_BAR();
}
__device__ __forceinline__ void o_step(const OLd& L, const LAS unsigned char* sb_cur, const LAS unsigned char* vfb_cur, bf16* O, int row0, int col0, int dh, int lane) {
    const int c = lane & 15, q = lane >> 4;
    f32x4 acc[2];
    acc[0] = (f32x4){0.f, 0.f, 0.f, 0.f}; acc[1] = acc[0];
#pragma unroll
    for (int s = 0; s < 4; ++s)
#pragma unroll
        for (int et = 0; et < 2; ++et) { const bf16x8 sf = *(const LAS bf16x8*)(sb_cur + (16 * et + c) * SB_STRIDE + (32 * s + 8 * q) * 2); acc[et] = MFMA16(sf, L.qf[s], acc[et]); }
#pragma unroll
    for (int et = 0; et < 2; ++et) { const bf16x8 vf = *(const LAS bf16x8*)(vfb_cur + ((2 * et + dh) * 64 + lane) * 16); acc[et] = MFMA16(vf, L.pf, acc[et]); }
    const int row = row0 + c;
    v4u w;
    asm volatile("s_nop 7\n\ts_nop 3\n\tv_cvt_pk_bf16_f32 %0, %4, %5\n\tv_cvt_pk_bf16_f32 %1, %6, %7\n\tv_cvt_pk_bf16_f32 %2, %8, %9\n\tv_cvt_pk_bf16_f32 %3, %10, %11"
                 : "=&v"(w.x), "=&v"(w.y), "=&v"(w.z), "=&v"(w.w)
                 : "v"(acc[0][0]), "v"(acc[0][1]), "v"(acc[0][2]), "v"(acc[0][3]), "v"(acc[1][0]), "v"(acc[1][1]), "v"(acc[1][2]), "v"(acc[1][3]));
    *(GAS v4u*)(O + (size_t)row * 2048 + col0 + 8 * q) = w;
    WG_BAR();
}
__device__ __forceinline__ void scan_phase(LAS unsigned char* lds, const bf16* QF, const bf16* KF, const bf16* PF, const bf16* VF, const float* EB, bf16* O0, bf16* O1, int G, int vid, int tid, int wave, int lane) {
    for (int item = vid; item < 256; item += G) {
        const int bh = item & 7, dh = (item >> 3) & 1, ne2 = item >> 4, b = bh >> 2, h = bh & 3; const size_t it0 = (size_t)bh * NCH;
        for (int i = tid; i < 2 * SB_BYTES / 4; i += 512) ((LAS unsigned*)lds)[i] = 0u;
        LAS unsigned char* vfb = lds + VFB_OFF;
        if (wave < 4) {
            f32x4 S[2][2];
#pragma unroll
            for (int et = 0; et < 2; ++et)
#pragma unroll
                for (int i = 0; i < 2; ++i) S[et][i] = (f32x4){0.f, 0.f, 0.f, 0.f};
            ULd A, B, C; u_load(A, KF, VF, EB, it0, ne2, dh, wave, lane); u_load(B, KF, VF, EB, it0 + 1, ne2, dh, wave, lane);
            *(LAS bf16x8*)(vfb + (wave * 64 + lane) * 16) = A.vfn;
            WG_BAR();
            int c = 0;
            for (; c < NCH - 2; c += 3) {
                u_load(C, KF, VF, EB, it0 + c + 2, ne2, dh, wave, lane);
                u_step(A, B, S, lds + ((c + 1) & 1) * SB_BYTES, vfb + (c & 1) * VFB_BYTES, vfb + ((c + 1) & 1) * VFB_BYTES, wave, lane);
                u_load(A, KF, VF, EB, it0 + c + 3, ne2, dh, wave, lane);
                u_step(B, C, S, lds + (c & 1) * SB_BYTES, vfb + ((c + 1) & 1) * VFB_BYTES, vfb + (c & 1) * VFB_BYTES, wave, lane);
                u_load(B, KF, VF, EB, it0 + (c + 4 < NCH ? c + 4 : NCH - 1), ne2, dh, wave, lane);
                u_step(C, A, S, lds + ((c + 1) & 1) * SB_BYTES, vfb + (c & 1) * VFB_BYTES, vfb + ((c + 1) & 1) * VFB_BYTES, wave, lane);
            }
            u_step(A, B, S, lds + ((c + 1) & 1) * SB_BYTES, vfb + (c & 1) * VFB_BYTES, vfb + ((c + 1) & 1) * VFB_BYTES, wave, lane);
            u_step(B, B, S, lds + (c & 1) * SB_BYTES, vfb + ((c + 1) & 1) * VFB_BYTES, vfb + (c & 1) * VFB_BYTES, wave, lane);
        } else {
            const int mt = wave - 4, col0 = h * DV + 32 * ne2, rb = b * TSEQ + 16 * mt; bf16* O = dh ? O1 : O0;
            OLd A, B, C; o_load(A, QF, PF, it0, dh, mt, lane); o_load(B, QF, PF, it0 + 1, dh, mt, lane);
            WG_BAR();
            int c = 0;
            for (; c < NCH - 2; c += 3) {
                o_load(C, QF, PF, it0 + c + 2, dh, mt, lane);
                o_step(A, lds + (c & 1) * SB_BYTES, vfb + (c & 1) * VFB_BYTES, O, rb + c * CH, col0, dh, lane);
                o_load(A, QF, PF, it0 + c + 3, dh, mt, lane);
                o_step(B, lds + ((c + 1) & 1) * SB_BYTES, vfb + ((c + 1) & 1) * VFB_BYTES, O, rb + (c + 1) * CH, col0, dh, lane);
                o_load(B, QF, PF, it0 + (c + 4 < NCH ? c + 4 : NCH - 1), dh, mt, lane);
                o_step(C, lds + (c & 1) * SB_BYTES, vfb + (c & 1) * VFB_BYTES, O, rb + (c + 2) * CH, col0, dh, lane);
            }
            o_step(A, lds + (c & 1) * SB_BYTES, vfb + (c & 1) * VFB_BYTES, O, rb + c * CH, col0, dh, lane);
            o_step(B, lds + ((c + 1) & 1) * SB_BYTES, vfb + ((c + 1) & 1) * VFB_BYTES, O, rb + (c + 1) * CH, col0, dh, lane);
        }
        WG_BAR();
    }
}

__device__ __forceinline__ void outgate_phase(bf16* O, const bf16* O1, const bf16* Gt, const float* gnw, int gw, int NGW, int qbase, int wave, int lane) {
    const f32x4 w0 = *(const GAS f32x4*)(gnw + lane * 8), w1 = *(const GAS f32x4*)(gnw + lane * 8 + 4);
    const float w[8] = {w0.x, w0.y, w0.z, w0.w, w1.x, w1.y, w1.z, w1.w};
    const int m_lo = qbase >= 0 ? 0 : gw, m_hi = qbase >= 0 ? 4 : M / 2, m_st = qbase >= 0 ? 1 : NGW;
    for (int mm = m_lo; mm < m_hi; mm += m_st) {
        const int rowA = qbase >= 0 ? qbase + wave * 8 + mm : mm, rowB = qbase >= 0 ? rowA + 4 : mm + M / 2;
        v4u ov[2][4], pv[2][4], gv[2][4];
#pragma unroll
        for (int rr = 0; rr < 2; ++rr)
#pragma unroll
            for (int j = 0; j < 4; ++j) { const size_t off = (size_t)(rr ? rowB : rowA) * 2048 + 512 * j + 8 * lane; ov[rr][j] = *(const GAS v4u*)(O + off); pv[rr][j] = *(const GAS v4u*)(O1 + off); gv[rr][j] = __builtin_nontemporal_load((const GAS v4u*)(Gt + off)); }
#pragma unroll
        for (int rr = 0; rr < 2; ++rr)
#pragma unroll
            for (int j = 0; j < 4; ++j) {
                float o[8], o1[8], g[8], y[8]; unpack8(ov[rr][j], o); unpack8(pv[rr][j], o1); unpack8(gv[rr][j], g);
#pragma unroll
                for (int i = 0; i < 8; ++i) o[i] += o1[i];
                float ss = 0.f;
#pragma unroll
                for (int i = 0; i < 8; ++i) ss += o[i] * o[i];
                const float rs = rsqrtf(wave_sum(ss) * (1.f / DV) + EPS);
#pragma unroll
                for (int i = 0; i < 8; ++i) y[i] = o[i] * rs * w[i] * g[i] * __builtin_amdgcn_rcpf(1.f + __expf(-g[i]));
                v4u r; r.x = pk2(y[0], y[1]); r.y = pk2(y[2], y[3]); r.z = pk2(y[4], y[5]); r.w = pk2(y[6], y[7]);
                *(GAS v4u*)(O + (size_t)(rr ? rowB : rowA) * 2048 + 512 * j + 8 * lane) = r;
            }
    }
}
__device__ __forceinline__ void final_norm_phase(const bf16* X2, float* out, const float* sumsq2, const float* w, int gt, int NT, int qbase) {
    const f32x4 wa = *(const GAS f32x4*)(w + (gt & 255) * 8), wb = *(const GAS f32x4*)(w + (gt & 255) * 8 + 4);
    const int pbeg = qbase >= 0 ? qbase * 256 + (gt & 511) : gt, pend = qbase >= 0 ? (qbase + 64) * 256 : M * 256; if (qbase >= 0) NT = 512;
    for (int p0 = pbeg; p0 < pend; p0 += 8 * NT) {
        v4u xv[8]; float ss[8];
#pragma unroll
        for (int k = 0; k < 8; ++k) { const int p = p0 + k * NT; if (p < pend) { xv[k] = __builtin_nontemporal_load((const GAS v4u*)(X2 + (size_t)p * 8)); ss[k] = sumsq2[p >> 8]; } }
#pragma unroll
        for (int k = 0; k < 8; ++k) { const int p = p0 + k * NT; if (p < pend) { const float rs = rsqrtf(ss[k] * (1.f / DM) + EPS); float x[8]; unpack8(xv[k], x);
            *(GAS f32x4*)(out + (size_t)p * 8) = (f32x4){x[0] * rs * wa.x, x[1] * rs * wa.y, x[2] * rs * wa.z, x[3] * rs * wa.w};
            *(GAS f32x4*)(out + (size_t)p * 8 + 4) = (f32x4){x[4] * rs * wb.x, x[5] * rs * wb.y, x[6] * rs * wb.z, x[7] * rs * wb.w}; } }
    }
}
#ifndef REP_P0
#define REP_P0 1
#endif
#ifndef REP_P1
#define REP_P1 1
#endif
#ifndef REP_P2
#define REP_P2 1
#endif
#ifndef REP_P5
#define REP_P5 1
#endif
#ifndef REP_P6
#define REP_P6 1
#endif
#ifndef REP_P4
#define REP_P4 1
#endif
#ifndef USE_XCD_BAR
#define USE_XCD_BAR 1
#endif
struct Args { const float* in[12]; float* out; unsigned char* ws; };
__global__ void __launch_bounds__(NWAVES * 64, 2) hybrid_fwd(Args a) {
    extern __shared__ __attribute__((aligned(16))) unsigned char lds_raw[];
    LAS unsigned char* lds = (LAS unsigned char*)lds_raw;
    cg::grid_group grid = cg::this_grid();
    const int tid = threadIdx.x, lane = tid & 63, wave = __builtin_amdgcn_readfirstlane(tid >> 6);
    const int G = gridDim.x, gw = blockIdx.x * NWAVES + wave, NGW = G * NWAVES, gt = blockIdx.x * (NWAVES * 64) + tid, NT = G * NWAVES * 64;
    unsigned char* ws = a.ws;
    const float* x = a.in[0]; const float* norm0_w = a.in[1]; const float* w_in0 = a.in[2]; const float* w_conv = a.in[3]; const float* w_out0 = a.in[4];
    const float* norm1_w = a.in[5]; const float* w_in1 = a.in[6]; const float* w_gk2 = a.in[7]; const float* b_gk2 = a.in[8]; const float* gn_w = a.in[9]; const float* w_out1 = a.in[10]; const float* normf_w = a.in[11];
    float* sumsq1 = (float*)(ws + WS_SUMSQ1); float* sumsq2 = (float*)(ws + WS_SUMSQ2); float* hsum = (float*)(ws + WS_HSUM);
    float* rstd0 = (float*)(ws + WS_RSTD0); float* gklr = (float*)(ws + WS_GKLR); float* eb = (float*)(ws + WS_EB);
    bf16* wgt = (bf16*)(ws + WS_WGT); bf16* w0t = (bf16*)(ws + WS_W0T); bf16* wo0t = (bf16*)(ws + WS_WO0T); bf16* w1t = (bf16*)(ws + WS_W1T); bf16* wo1t = (bf16*)(ws + WS_WO1T);
    bf16* bufA = (bf16*)(ws + WS_BUFA); bf16* bufB = (bf16*)(ws + WS_BUFB); bf16* bufC = (bf16*)(ws + WS_BUFC); bf16* bufD = (bf16*)(ws + WS_BUFD);
    bf16* x1b = (bf16*)(ws + WS_X1);
    bf16* vf = (bf16*)(ws + WS_VF); bf16* qf = bufC; bf16* kf = bufC + (size_t)16 * 1024 * 1024; bf16* pf = (bf16*)(ws + WS_PF);
#if USE_XCD_BAR
    volatile LAS unsigned* misc = (volatile LAS unsigned*)(lds + LDS_BYTES - 64);
    unsigned* ctlw = (unsigned*)(ws + WS_CTL);
    constexpr int CW_PROG = 8192;
    constexpr int CW_XQID = 12288, CW_BAD = 12800, CW_QCNT = 16384;
    if (tid == 0) { misc[0] = 0u; misc[1] = 0u; __hip_atomic_store(ctlw + CW_XQID + blockIdx.x, xb_xcc_id() + 1u, __ATOMIC_RELAXED, __HIP_MEMORY_SCOPE_AGENT); }
    __syncthreads();
    XcdBarrier xbar = xcd_barrier_post((unsigned*)(ws + WS_CTL) + 1024, (volatile LAS unsigned*)(lds + LDS_BYTES - 64));
    if (a.ws == nullptr) grid.sync();
#define GRID_BAR() xcd_barrier(xbar)
#else
#define GRID_BAR() grid.sync()
#endif

    for (int rep = 0; rep < REP_P0; ++rep) {
        LAS float* scr = (LAS float*)(lds + wave * 16384);
        constexpr int I0 = 32 * 256, IO = 32 * 64, I1 = 32 * 192, NITEMS = I0 + IO + I1 + IO;
        for (int it = gw; it < NITEMS; it += NGW) {
            int r = it;
            if (r < IO) { p0_transpose_item(w_out1, DM, 64, DM, wo1t, 0, nullptr, scr, r, lane); continue; } r -= IO;
            if (r < I1) { p0_transpose_item(w_in1, N1RAW, 192, DM, w1t, 2, norm1_w, scr, r, lane); continue; } r -= I1;
            if (r < IO) { p0_transpose_item(w_out0, DM, 64, DM, wo0t, 0, nullptr, scr, r, lane); continue; } r -= IO;
            p0_transpose_item(w_in0, N0, 256, DM, w0t, 1, nullptr, scr, r, lane);
        }
        for (int p = gt; p < 16 * DM; p += NT) { const int n = p >> 11, k = p & (DM - 1); wgt[p] = (bf16)(pk2(w_in1[(size_t)k * N1RAW + N1 + n] * norm1_w[k], 0.f) & 0xffffu); }
        for (int m = gw; m < M / 2; m += NGW) rms_rows2_to_bf16(x + (size_t)m * DM, x + (size_t)(m + M / 2) * DM, norm0_w, bufA + (size_t)m * DM, bufA + (size_t)(m + M / 2) * DM, rstd0 + m, rstd0 + m + M / 2, lane);
    }
    GRID_BAR();
    const int vid = (int)blockIdx.x;
    if (tid == 0) { bool ok = (G == 256);
        if (ok) { const unsigned a0 = xb_ld(ctlw + CW_XQID + (vid & 63)), a1 = xb_ld(ctlw + CW_XQID + (vid & 63) + 64), a2 = xb_ld(ctlw + CW_XQID + (vid & 63) + 128), a3 = xb_ld(ctlw + CW_XQID + (vid & 63) + 192);
                  ok = (a0 != 0u) && a0 == a1 && a1 == a2 && a2 == a3; }
        if (!ok) xb_add(ctlw + CW_BAD, 1u); }
    for (int rep = 0; rep < REP_P1; ++rep) {
        pg8::Gemm g{bufA, w0t, M, N0, DM}; pg8::StaticOrder S; S.init(M, N0, G, vid);
        pg8::EpiConvFused E{bufB, w_conv, (float*)(ws + WS_HA), (float*)(ws + WS_HB), (LAS float*)(lds + 131072)};
        pg8::gemm_phase<pg8::EpiConvFused, pg8::StaticOrder, true, true>(lds, g, S, E);
    }
    GRID_BAR();
    if (tid == 0) misc[5] = (xb_ld(ctlw + CW_BAD) == 0u) ? 1u : 0u;
    __syncthreads();
    const bool quadmode = __builtin_amdgcn_readfirstlane((int)misc[5]) != 0;
    unsigned* qcnt = ctlw + CW_QCNT + 64 * (vid & 63); unsigned qgen = 0u;
    int qpm = -1; if (quadmode) { pg8::StaticOrder S; S.init(M, DM, G, vid); pg8::Unit u0; (void)S.next(0, u0); qpm = u0.pm; }
#define QUAD_OR_GRID_BAR() do { if (quadmode) { \
        asm volatile("s_waitcnt vmcnt(0)" ::: "memory"); __syncthreads(); \
        if (tid == 0) { (void)xb_add(qcnt, 1u); const unsigned want_ = 4u * (qgen + 1u); unsigned sp_ = 0u; \
            while (xb_ld(qcnt) < want_) { __builtin_amdgcn_s_sleep(1); if (++sp_ > (1u << 22)) break; } \
            __builtin_amdgcn_fence(__ATOMIC_ACQUIRE, "agent"); asm volatile("s_waitcnt vmcnt(0)" ::: "memory"); } \
        ++qgen; __syncthreads(); } else { GRID_BAR(); } } while (0)
    {
        pg8::Gemm g{bufB, wo0t, M, DM, DM}; pg8::StaticOrder S; S.init(M, DM, G, vid);
        { pg8::Unit uu; int last = -1;
          for (int i = 0; S.next(i, uu); ++i) if (uu.pm != last) { conv_fix_panel((const float*)(ws + WS_HA), (const float*)(ws + WS_HB), w_conv, bufB, uu.pm, tid); last = uu.pm; }
          asm volatile("s_waitcnt vmcnt(0)" ::: "memory"); __syncthreads(); }
        pg8::EpiResid<2> E{bufA, x1b, sumsq1, rstd0, norm0_w};
        pg8::gemm_phase<pg8::EpiResid<2>, pg8::StaticOrder, true, true>(lds, g, S, E);
    }
    QUAD_OR_GRID_BAR();
    for (int rep = 0; rep < REP_P4; ++rep) {
        pg8::Gemm g{x1b, w1t, M, N1, DM}; pg8::StaticOrder S; S.init(M, N1, G, vid);
        pg8::EpiQKVG E{bufA, (long)((WS_BUFD - WS_BUFA) / 2), vf, sumsq1, lds + 133120};
        pg8::gemm_phase<pg8::EpiQKVG, pg8::StaticOrder, true, true>(lds, g, S, E);
        { pg8::Unit u0; (void)S.next(0, u0); gklr_phase(lds, x1b, wgt, sumsq1, gklr, G, quadmode ? 16 * u0.pm + 4 * (vid >> 6) : (int)blockIdx.x * 4, wave, lane); }
    }
    QUAD_OR_GRID_BAR();
    for (int rep = 0; rep < REP_P5; ++rep) gate_phase(lds, bufA, bufC, gklr, w_gk2, b_gk2, qf, kf, pf, vf, eb, G, vid, qpm, tid, wave, lane);
    GRID_BAR();
    scan_phase(lds, qf, kf, pf, vf, eb, bufA, bufB, G, vid, tid, wave, lane);
    GRID_BAR();
    outgate_phase(bufA, bufB, bufD, gn_w, gw, NGW, qpm >= 0 ? 256 * qpm + 64 * (vid >> 6) : -1, wave, lane);
    QUAD_OR_GRID_BAR();
    {
        pg8::Gemm g{bufA, wo1t, M, DM, DM}; pg8::StaticOrder S; S.init(M, DM, G, vid);
        pg8::EpiResid<1> E{x1b, bufB, sumsq2, nullptr, nullptr};
        pg8::gemm_phase<pg8::EpiResid<1>, pg8::StaticOrder, true, true>(lds, g, S, E);
    }
    QUAD_OR_GRID_BAR();
    final_norm_phase(bufB, a.out, sumsq2, normf_w, gt, NT, qpm >= 0 ? 256 * qpm + 64 * (vid >> 6) : -1);
}

extern "C" void kernel_launch(void* const* d_in, const int* in_sizes, int n_in, void* d_out, int out_size, void* d_ws, size_t ws_size, hipStream_t stream) {
    static int grid = 0;
    if (grid == 0) {
        if (n_in != 12 || in_sizes[0] != M * DM || out_size != M * DM || ws_size < WS_END) { fprintf(stderr, "kernel_launch: unexpected shapes (n_in %d, in0 %d, out %d, ws %zu); nothing launched\n", n_in, n_in > 0 ? in_sizes[0] : -1, out_size, ws_size); grid = -1; return; }
        int dev = 0, cus = 0, per_cu = 0;
        if (hipGetDevice(&dev) != hipSuccess || hipDeviceGetAttribute(&cus, hipDeviceAttributeMultiprocessorCount, dev) != hipSuccess) { fprintf(stderr, "kernel_launch: device query failed\n"); grid = -1; return; }
        if (hipFuncSetAttribute((const void*)hybrid_fwd, hipFuncAttributeMaxDynamicSharedMemorySize, LDS_BYTES) != hipSuccess) { fprintf(stderr, "kernel_launch: hipFuncSetAttribute failed\n"); grid = -1; return; }
        if (hipOccupancyMaxActiveBlocksPerMultiprocessor(&per_cu, (const void*)hybrid_fwd, NWAVES * 64, LDS_BYTES) != hipSuccess || per_cu < 1) { fprintf(stderr, "kernel_launch: occupancy query says %d blocks per CU\n", per_cu); per_cu = 1; }
        (void)hipGetLastError();
        grid = cus * per_cu;
    }
    if (grid < 0) return;
    (void)hipMemsetAsync((char*)d_ws + WS_CTL, 0, CTL_ZERO_BYTES, stream);
    Args a{};
    for (int i = 0; i < 12; ++i) a.in[i] = (const float*)d_in[i];
    a.out = (float*)d_out; a.ws = (unsigned char*)d_ws;
    void* params[] = {&a};
    hipError_t e = hipLaunchCooperativeKernel((const void*)hybrid_fwd, dim3(grid), dim3(NWAVES * 64), params, LDS_BYTES, stream);
    if (e != hipSuccess) fprintf(stderr, "kernel_launch: cooperative launch failed: %s (grid %d)\n", hipGetErrorString(e), grid);
}
```
